# Optimizing an MI355X kernel written in HIP

```python
import jax
import jax.numpy as jnp
from jax import lax
import numpy as np

D_MODEL = 2048
BATCH = 1
SEQ = 8192
DEPTH = 4

A_HEADS = 8
A_KV_GROUPS = 2
A_HPG = A_HEADS // A_KV_GROUPS
HEAD_DIM = 128
A_WIDTH = A_HEADS * HEAD_DIM
A_KV_WIDTH = A_KV_GROUPS * HEAD_DIM
CMP_BLOCK = 32
CMP_STRIDE = 16
SEL_BLOCK = 64
SEL_TOPK = 16
WINDOW = 512
Q_BLOCK = 128
ROPE_THETA = 10000.0
HG_HEADS = 8
HG_DIM = 128
HG_WIDTH = HG_HEADS * HG_DIM
HG_CHUNK = 64
D_FF = 5632
CONV_WIDTH = 3
NORM_EPS = 1e-6
N_ADA = 6
IN_SIZES = (A_WIDTH, 6 * A_KV_WIDTH, 3 * A_HEADS, HG_WIDTH, HG_WIDTH, HG_WIDTH, HG_WIDTH, 2 * D_MODEL)
IN_COLS = A_WIDTH + 6 * A_KV_WIDTH + 3 * A_HEADS + 4 * HG_WIDTH + 2 * D_MODEL

kernel_name = 'hybrid_nsa_hgrn2_convffn_adaln_trunk'


def split_cols(z, sizes):
    out = []
    off = 0
    for s in sizes:
        out.append(z[..., off:off + s])
        off += s
    return out


def rms_norm(t, g):
    tf = t.astype(jnp.float32)
    y = tf * lax.rsqrt(jnp.mean(tf * tf, axis=-1, keepdims=True) + NORM_EPS)
    return (y * g.astype(jnp.float32)).astype(t.dtype)


def rope_tables(positions):
    inv_freq = 1.0 / (ROPE_THETA ** (jnp.arange(0, HEAD_DIM, 2, dtype=jnp.float32) / HEAD_DIM))
    ang = positions.astype(jnp.float32)[..., None] * inv_freq
    return jnp.cos(ang)[:, :, None, :], jnp.sin(ang)[:, :, None, :]


def apply_rope(t, cos, sin):
    tf = t.astype(jnp.float32)
    t1, t2 = jnp.split(tf, 2, axis=-1)
    return jnp.concatenate([t1 * cos - t2 * sin, t2 * cos + t1 * sin], axis=-1).astype(t.dtype)


def compress_blocks(t, pos_emb, w):
    B, S, G, hd = t.shape
    n = (S - CMP_BLOCK) // CMP_STRIDE + 1
    idx = jnp.arange(n)[:, None] * CMP_STRIDE + jnp.arange(CMP_BLOCK)[None, :]
    blocks = t[:, idx] + pos_emb[None, None, :, None, :]
    blocks = blocks.transpose(0, 1, 3, 2, 4).reshape(B, n, G, CMP_BLOCK * hd)
    return blocks @ w


def masked_softmax(s, mask):
    s = jnp.where(mask, s, -jnp.inf)
    m = jnp.max(s, axis=-1, keepdims=True)
    m = jnp.where(jnp.isfinite(m), m, 0.0)
    p = jnp.exp(s - m)
    den = jnp.sum(p, axis=-1, keepdims=True)
    return p / jnp.where(den > 0, den, 1.0)


def nsa_sequence(q, k_cmp, v_cmp, k_sel, v_sel, k_win, v_win, gates):
    S = q.shape[0]
    n_cmp = k_cmp.shape[0]
    n_sel = S // SEL_BLOCK
    topk = min(SEL_TOPK, n_sel)
    scale = HEAD_DIM ** -0.5
    cmp_start = jnp.arange(n_cmp) * CMP_STRIDE
    cmp_last = cmp_start + CMP_BLOCK - 1
    sel_start = jnp.arange(n_sel) * SEL_BLOCK
    overlap = jnp.maximum(
        jnp.minimum(cmp_start[:, None] + CMP_BLOCK, sel_start[None, :] + SEL_BLOCK)
        - jnp.maximum(cmp_start[:, None], sel_start[None, :]), 0).astype(jnp.float32) / CMP_BLOCK
    ks_blk = k_sel.reshape(n_sel, SEL_BLOCK, A_KV_GROUPS, HEAD_DIM).transpose(2, 0, 1, 3)
    vs_blk = v_sel.reshape(n_sel, SEL_BLOCK, A_KV_GROUPS, HEAD_DIM).transpose(2, 0, 1, 3)
    kw_pad = jnp.pad(k_win, ((WINDOW, 0), (0, 0), (0, 0)))
    vw_pad = jnp.pad(v_win, ((WINDOW, 0), (0, 0), (0, 0)))
    blk_ids = jnp.arange(n_sel)
    in_blk = jnp.arange(SEL_BLOCK)
    win_off = jnp.arange(Q_BLOCK + WINDOW) - WINDOW

    def one_block(bi):
        t0 = bi * Q_BLOCK
        tpos = t0 + jnp.arange(Q_BLOCK)
        qb = lax.dynamic_slice_in_dim(q, t0, Q_BLOCK, 0).reshape(Q_BLOCK, A_KV_GROUPS, A_HPG, HEAD_DIM) * scale
        gb = lax.dynamic_slice_in_dim(gates, t0, Q_BLOCK, 0).reshape(Q_BLOCK, A_KV_GROUPS, A_HPG, 3)
        s_c = jnp.einsum('qghd,ngd->ghqn', qb, k_cmp)
        p_c = masked_softmax(s_c, (cmp_last[None, :] <= tpos[:, None])[None, None])
        o_c = jnp.einsum('ghqn,ngd->qghd', p_c, v_cmp)
        imp = jnp.einsum('ghqn,nm->gqm', p_c, overlap)
        cur = tpos // SEL_BLOCK
        forced = (blk_ids[None] == 0) | (blk_ids[None] == cur[:, None]) | (blk_ids[None] == cur[:, None] - 1)
        valid = sel_start[None] <= tpos[:, None]
        imp = jnp.where(forced[None], jnp.inf, jnp.where(valid[None], imp, -jnp.inf))
        _, idx = lax.top_k(imp, topk)
        kg = jax.vmap(lambda kb, ix: kb[ix])(ks_blk, idx).reshape(A_KV_GROUPS, Q_BLOCK, topk * SEL_BLOCK, HEAD_DIM)
        vg = jax.vmap(lambda vb, ix: vb[ix])(vs_blk, idx).reshape(A_KV_GROUPS, Q_BLOCK, topk * SEL_BLOCK, HEAD_DIM)
        kpos = (idx[..., None] * SEL_BLOCK + in_blk).reshape(A_KV_GROUPS, Q_BLOCK, topk * SEL_BLOCK)
        s_s = jnp.einsum('qghd,gqkd->ghqk', qb, kg)
        p_s = masked_softmax(s_s, (kpos <= tpos[None, :, None])[:, None])
        o_s = jnp.einsum('ghqk,gqkd->qghd', p_s, vg)
        kwb = lax.dynamic_slice_in_dim(kw_pad, t0, Q_BLOCK + WINDOW, 0)
        vwb = lax.dynamic_slice_in_dim(vw_pad, t0, Q_BLOCK + WINDOW, 0)
        wpos = t0 + win_off
        dist = tpos[:, None] - wpos[None, :]
        mask_w = (dist >= 0) & (dist < WINDOW) & (wpos[None, :] >= 0)
        s_w = jnp.einsum('qghd,kgd->ghqk', qb, kwb)
        p_w = masked_softmax(s_w, mask_w[None, None])
        o_w = jnp.einsum('ghqk,kgd->qghd', p_w, vwb)
        o = gb[..., 0:1] * o_c + gb[..., 1:2] * o_s + gb[..., 2:3] * o_w
        return o.reshape(Q_BLOCK, A_WIDTH)

    out = lax.map(one_block, jnp.arange(S // Q_BLOCK))
    return out.reshape(S, A_WIDTH)


def hgrn2_recurrence(q, f_pre, v, lb):
    B, S, H, d = q.shape
    lb = lb.reshape(H, d)
    log_f = jnp.logaddexp(jnp.log(lb), jnp.log1p(-lb) + jax.nn.log_sigmoid(f_pre))
    k = -jnp.expm1(log_f)
    nc = S // HG_CHUNK

    def to_chunks(t):
        return t.reshape(B, nc, HG_CHUNK, H, t.shape[-1]).transpose(1, 0, 3, 2, 4)

    causal = jnp.tril(jnp.ones((HG_CHUNK, HG_CHUNK), dtype=bool))[:, :, None]

    def step(state, inp):
        qc, kc, vc, gc = inp
        b = jnp.cumsum(gc, axis=2)
        diff = b[:, :, :, None, :] - b[:, :, None, :, :]
        decay = jnp.where(causal, jnp.exp(jnp.where(causal, diff, 0.0)), 0.0)
        scores = jnp.einsum('bhtd,bhsd,bhtsd->bhts', qc, kc, decay)
        o = jnp.einsum('bhts,bhsv->bhtv', scores, vc) + jnp.einsum('bhtd,bhdv->bhtv', qc * jnp.exp(b), state)
        b_last = b[:, :, -1:, :]
        state = jnp.exp(b_last[:, :, 0, :])[..., None] * state + jnp.einsum('bhsd,bhsv->bhdv', kc * jnp.exp(b_last - b), vc)
        return state, o

    state0 = jnp.zeros((B, H, d, v.shape[-1]), jnp.float32)
    _, o = lax.scan(step, state0, (to_chunks(q), to_chunks(k), to_chunks(v), to_chunks(log_f)))
    return o.transpose(1, 0, 3, 2, 4).reshape(B, S, H, v.shape[-1])


def causal_depthwise_conv(u, w, b):
    S = u.shape[1]
    u_pad = jnp.pad(u, ((0, 0), (CONV_WIDTH - 1, 0), (0, 0)))
    out = b + w[0] * u_pad[:, 0:S]
    for j in range(1, CONV_WIDTH):
        out = out + w[j] * u_pad[:, j:j + S]
    return out


def setup_inputs(seed: int = 0) -> dict:
    key = jax.random.key(seed)
    k = jax.random.split(key, 24)

    def nrm(kk, shape, scale):
        return jax.random.normal(kk, shape, jnp.float32) * scale

    L = DEPTH
    D = D_MODEL
    return {
        'x': nrm(k[0], (BATCH, SEQ, D), 1.0),
        'c': nrm(k[1], (BATCH, D), 1.0),
        'positions': jnp.broadcast_to(jnp.arange(SEQ, dtype=jnp.int32), (BATCH, SEQ)),
        'w_ada': nrm(k[2], (L, D, N_ADA * D), 0.5 * D ** -0.5),
        'b_ada': nrm(k[3], (L, N_ADA * D), 0.02),
        'g_pre_mix': 1.0 + nrm(k[4], (L, D), 0.05),
        'w_in': nrm(k[5], (L, D, IN_COLS), D ** -0.5),
        'pe_kc': nrm(k[6], (L, CMP_BLOCK, HEAD_DIM), 0.1),
        'w_kc': nrm(k[7], (L, CMP_BLOCK * HEAD_DIM, HEAD_DIM), (CMP_BLOCK * HEAD_DIM) ** -0.5),
        'pe_vc': nrm(k[8], (L, CMP_BLOCK, HEAD_DIM), 0.1),
        'w_vc': nrm(k[9], (L, CMP_BLOCK * HEAD_DIM, HEAD_DIM), (CMP_BLOCK * HEAD_DIM) ** -0.5),
        'lb_logits': nrm(k[10], (L, HG_WIDTH), 1.0),
        'g_hg_norm': 1.0 + nrm(k[11], (L, HG_WIDTH), 0.05),
        'w_br_attn': nrm(k[12], (L, A_WIDTH, D), A_WIDTH ** -0.5),
        'w_br_hgrn': nrm(k[13], (L, HG_WIDTH, D), HG_WIDTH ** -0.5),
        'w_out': nrm(k[14], (L, D, D), D ** -0.5),
        'g_post_mix': 1.0 + nrm(k[15], (L, D), 0.05),
        'g_pre_ffn': 1.0 + nrm(k[16], (L, D), 0.05),
        'w_up': nrm(k[17], (L, D, 2 * D_FF), D ** -0.5),
        'conv_w': nrm(k[18], (L, CONV_WIDTH, 2 * D_FF), CONV_WIDTH ** -0.5),
        'conv_b': nrm(k[19], (L, 2 * D_FF), 0.02),
        'w_down': nrm(k[20], (L, D_FF, D), D_FF ** -0.5),
        'g_post_ffn': 1.0 + nrm(k[21], (L, D), 0.05),
    }


def reference(x, c, positions, w_ada, b_ada, g_pre_mix, w_in, pe_kc, w_kc, pe_vc, w_vc, lb_logits, g_hg_norm,
              w_br_attn, w_br_hgrn, w_out, g_post_mix, g_pre_ffn, w_up, conv_w, conv_b, w_down, g_post_ffn):
    B, S, D = x.shape
    dt = x.dtype
    cos, sin = rope_tables(positions)
    lb_cum = jnp.cumsum(jax.nn.softmax(lb_logits.astype(jnp.float32), axis=0), axis=0)
    lower_bounds = lb_cum - lb_cum[0:1]
    c_act = jax.nn.silu(c)

    def f32(t):
        return t.astype(jnp.float32)

    for l in range(DEPTH):
        ada = (c_act @ w_ada[l] + b_ada[l])[:, None, :]
        sh1, sc1, gt1, sh2, sc2, gt2 = jnp.split(ada, N_ADA, axis=-1)

        h = rms_norm(x, g_pre_mix[l]) * (1.0 + sc1) + sh1
        z = h @ w_in[l]
        q_a, kv, a_gate, q_h, f_h, i_h, og_h, m_gate = split_cols(z, IN_SIZES)

        q_a = apply_rope(q_a.reshape(B, S, A_HEADS, HEAD_DIM), cos, sin)
        kc_raw, vc_raw, k_sel, v_sel, k_win, v_win = [
            t.reshape(B, S, A_KV_GROUPS, HEAD_DIM) for t in jnp.split(kv, 6, axis=-1)]
        kc_raw = apply_rope(kc_raw, cos, sin)
        k_sel = apply_rope(k_sel, cos, sin)
        k_win = apply_rope(k_win, cos, sin)
        k_cmp = compress_blocks(kc_raw, pe_kc[l], w_kc[l])
        v_cmp = compress_blocks(vc_raw, pe_vc[l], w_vc[l])
        branch_gates = jax.nn.sigmoid(f32(a_gate)).reshape(B, S, A_HEADS, 3)
        attn = jax.vmap(nsa_sequence)(f32(q_a), f32(k_cmp), f32(v_cmp), f32(k_sel), f32(v_sel),
                                      f32(k_win), f32(v_win), branch_gates).astype(dt)

        hg = hgrn2_recurrence(f32(q_h).reshape(B, S, HG_HEADS, HG_DIM),
                              f32(f_h).reshape(B, S, HG_HEADS, HG_DIM),
                              f32(i_h).reshape(B, S, HG_HEADS, HG_DIM),
                              lower_bounds[l]).astype(dt)
        hg = rms_norm(hg, g_hg_norm[l].reshape(HG_HEADS, HG_DIM)) * jax.nn.silu(og_h.reshape(B, S, HG_HEADS, HG_DIM))
        hg = hg.reshape(B, S, HG_WIDTH)

        g_attn, g_hgrn = jnp.split(jax.nn.sigmoid(m_gate), 2, axis=-1)
        mixed = g_attn * (attn @ w_br_attn[l]) + g_hgrn * (hg @ w_br_hgrn[l])
        x = x + gt1 * rms_norm(mixed @ w_out[l], g_post_mix[l])

        h = rms_norm(x, g_pre_ffn[l]) * (1.0 + sc2) + sh2
        u = causal_depthwise_conv(h @ w_up[l], conv_w[l], conv_b[l])
        u_gate, u_val = jnp.split(u, 2, axis=-1)
        x = x + gt2 * rms_norm((jax.nn.silu(u_gate) * u_val) @ w_down[l], g_post_ffn[l])
    return x
```

```cpp
#include <hip/hip_runtime.h>
#include <cstdio>
#include <cstdint>
namespace pg8 {
#define PG8_LAS __attribute__((address_space(3)))
typedef unsigned short bf16_t;
typedef short bf16x8 __attribute__((ext_vector_type(8)));
typedef float f32x4 __attribute__((ext_vector_type(4)));
typedef unsigned u32x4 __attribute__((ext_vector_type(4)));
constexpr int BM = 256, BK = 64, HALF = 128, HTB = HALF * BK * 2  , STAGE_BYTES = 8 * HTB, NXCD = 8, WGM = 8;

__host__ __device__ __forceinline__ int lds_byte(int r, int c) { const int st = (r >> 4) * 2 + (c >> 5), rr = r & 15, cc = c & 31, ob = rr * 64 + cc * 2; return st * 1024 + (ob ^ (((ob >> 9) & 1) << 5)); }
__host__ __device__ __forceinline__ void stage_rc(int b, int& R, int& C) { const int st = b / 1024, sb = b % 1024, swz = sb ^ (((sb >> 9) & 1) << 5); R = (st >> 1) * 16 + swz / 64; C = (st & 1) * 32 + (swz % 64) / 2; }
__host__ __device__ __forceinline__ int perm32(int rho) { const int n = rho >> 4, i = rho & 15; return 8 * (i >> 2) + 4 * n + (i & 3); }

struct Unit { int pm, pn; };
struct Gemm { const bf16_t* A; const bf16_t* Bt; int M, N, K; };

struct StaticOrder {
    int nM, nN, nwg, G, c;
    __host__ __device__ void init(int M, int N, int G_, int c_) { nM = M / BM; nN = N / BM; nwg = nM * nN; G = G_; c = c_; }
    __host__ __device__ bool next(int i, Unit& u) const {
        const long L = (long)i * G + c; if (L >= nwg) return false;
        int wgid = (int)L; { const int q = nwg / NXCD, r = nwg % NXCD, xcd = wgid % NXCD, off = wgid / NXCD; wgid = (xcd < r ? xcd * (q + 1) : r * (q + 1) + (xcd - r) * q) + off; }
        const int nig = WGM * nN, gid = wgid / nig, fm = gid * WGM, gsz = (nM - fm) < WGM ? (nM - fm) : WGM;
        u.pm = fm + ((wgid % nig) % gsz); u.pn = (wgid % nig) / gsz; return true;
    }
    __device__ __forceinline__ void a_ready(const Unit&) const {}
    __device__ __forceinline__ void done(const Unit&) const {}
};
struct CountedOrder : StaticOrder {
    const unsigned* ready; unsigned need; unsigned* tmo;
    __device__ __forceinline__ void a_ready(const Unit& u) const {
        if (threadIdx.x < 64) {
            const unsigned long long t0 = __builtin_amdgcn_s_memrealtime(); unsigned polls = 0;
            while ((unsigned)__builtin_amdgcn_readfirstlane(__hip_atomic_load(ready + 64 * u.pm, __ATOMIC_RELAXED, __HIP_MEMORY_SCOPE_AGENT)) < need) {
                if ((++polls & 255u) == 0u && __builtin_amdgcn_readfirstlane(__hip_atomic_load(tmo, __ATOMIC_RELAXED, __HIP_MEMORY_SCOPE_AGENT)) != 0u) break;
                if (__builtin_amdgcn_s_memrealtime() - t0 > 2000000ull) {
                    if (threadIdx.x == 0) { unsigned expect = 0u; __hip_atomic_compare_exchange_strong(tmo + 1, &expect, 0x600u | (unsigned)(u.pm & 0xff), __ATOMIC_RELAXED, __ATOMIC_RELAXED, __HIP_MEMORY_SCOPE_AGENT); __hip_atomic_store(tmo, 1u, __ATOMIC_RELAXED, __HIP_MEMORY_SCOPE_AGENT); }
                    break; }
                __builtin_amdgcn_s_sleep(2); }
            __builtin_amdgcn_fence(__ATOMIC_ACQUIRE, "agent");
            asm volatile("s_waitcnt vmcnt(0)" ::: "memory");
        }
#if !defined(BROKEN_HOOK_NO_BARRIER)
        asm volatile("" ::: "memory"); __builtin_amdgcn_s_barrier(); asm volatile("" ::: "memory");
#endif
    }
};

__device__ __forceinline__ unsigned cvt_pk_bf16(float lo, float hi) { unsigned r; asm volatile("v_cvt_pk_bf16_f32 %0, %1, %2" : "=v"(r) : "v"(lo), "v"(hi)); return r; }
typedef float f32x2 __attribute__((ext_vector_type(2)));
__device__ __forceinline__ f32x2 gelu_pk(f32x2 v) {
    const f32x2 av = __builtin_elementwise_abs(v), d = av * 0.2316418882f + 1.0f;
    f32x2 t; t.x = __builtin_amdgcn_rcpf(d.x); t.y = __builtin_amdgcn_rcpf(d.y);
    f32x2 q = t * 0.5307027145f + (-0.7265760135f); q = q * t + 0.7107068705f; q = q * t + (-0.142248368f); q = q * t + 0.127414796f; q = q * t;
    const f32x2 s = (v * v) * (-0.72134752044f);
    f32x2 e; e.x = __builtin_amdgcn_exp2f(s.x); e.y = __builtin_amdgcn_exp2f(s.y);
    const f32x2 m = v * (q * e), r = v - m;
    f32x2 o; o.x = v.x < 0.f ? m.x : r.x; o.y = v.y < 0.f ? m.y : r.y; return o;
}

struct EpiF32 {
    static constexpr bool PERM = false, AFTER_DRAIN = false;
    float* C; int ldc; const float* bias;
    __device__ __forceinline__ void operator()(const f32x4 (&acc)[2][2][4][2], const Unit& u, int wr, int wc, int fr, int fq) const {
        const int row0 = u.pm * BM + wr * 64 + fr, col0 = u.pn * BM + wc * 32 + 4 * fq;
        f32x4 bv[2][2];
#pragma unroll
        for (int bj = 0; bj < 2; ++bj)
#pragma unroll
            for (int n = 0; n < 2; ++n) bv[bj][n] = bias ? *(const f32x4*)(bias + col0 + bj * HALF + n * 16) : (f32x4){0.f, 0.f, 0.f, 0.f};
#pragma unroll
        for (int ai = 0; ai < 2; ++ai)
#pragma unroll
            for (int m = 0; m < 4; ++m) { float* rowp = C + (size_t)(row0 + ai * HALF + m * 16) * ldc + col0;
#pragma unroll
                for (int bj = 0; bj < 2; ++bj)
#pragma unroll
                    for (int n = 0; n < 2; ++n) *(f32x4*)(rowp + bj * HALF + n * 16) = acc[ai][bj][m][n] + bv[bj][n]; }
    }
};
template <int ACT  > struct EpiBf16 {
    static constexpr bool PERM = true, AFTER_DRAIN = false;
    bf16_t* O; int ldc; const float* bias; int split_cols; size_t split_stride;
    __device__ __forceinline__ void operator()(const f32x4 (&acc)[2][2][4][2], const Unit& u, int wr, int wc, int fr, int fq) const {
        const int row0 = u.pm * BM + wr * 64 + fr; int colt = u.pn * BM; bf16_t* base = O;
        if (split_cols) { const int t = colt / split_cols; base += (size_t)t * split_stride; colt -= t * split_cols; }
        const int col0 = colt + wc * 32 + 8 * fq, bcol0 = u.pn * BM + wc * 32 + 8 * fq;
        f32x4 bv[2][2];
#pragma unroll
        for (int bj = 0; bj < 2; ++bj)
#pragma unroll
            for (int n = 0; n < 2; ++n) bv[bj][n] = bias ? *(const f32x4*)(bias + bcol0 + bj * HALF + 4 * n) : (f32x4){0.f, 0.f, 0.f, 0.f};
#pragma unroll
        for (int ai = 0; ai < 2; ++ai)
#pragma unroll
            for (int m = 0; m < 4; ++m) { bf16_t* rowp = base + (size_t)(row0 + ai * HALF + m * 16) * ldc + col0;
#pragma unroll
                for (int bj = 0; bj < 2; ++bj) { f32x4 v0 = acc[ai][bj][m][0] + bv[bj][0], v1 = acc[ai][bj][m][1] + bv[bj][1];
                    if (ACT == 1) { f32x2 a = gelu_pk((f32x2){v0[0], v0[1]}), b = gelu_pk((f32x2){v0[2], v0[3]}), c = gelu_pk((f32x2){v1[0], v1[1]}), d = gelu_pk((f32x2){v1[2], v1[3]});
                        v0 = (f32x4){a.x, a.y, b.x, b.y}; v1 = (f32x4){c.x, c.y, d.x, d.y}; }
                    if (ACT == 2) {
#pragma unroll
                        for (int j = 0; j < 4; ++j) { v0[j] = 0.5f * v0[j] * (1.0f + erff(v0[j] * 0.70710678f)); v1[j] = 0.5f * v1[j] * (1.0f + erff(v1[j] * 0.70710678f)); } }
                    u32x4 w; w.x = cvt_pk_bf16(v0[0], v0[1]); w.y = cvt_pk_bf16(v0[2], v0[3]); w.z = cvt_pk_bf16(v1[0], v1[1]); w.w = cvt_pk_bf16(v1[2], v1[3]);
                    *(u32x4*)(rowp + bj * HALF) = w; } }
    }
};

struct PanelStats {
    unsigned* xbuf;
    unsigned* cnt;
    unsigned* tmo;
    int ntn; float eps;
    unsigned code;
    __device__ __forceinline__ bool run(const f32x4 (&v)[2][2][4][2], const Unit& u, int wr, int wc, int fr, int fq, PG8_LAS unsigned char* lds, int wid, int lane) const {
        typedef float f32x2v __attribute__((ext_vector_type(2)));
        PG8_LAS f32x2v* P = (PG8_LAS f32x2v*)lds;
        PG8_LAS f32x2v* S = (PG8_LAS f32x2v*)(lds + 8192);
        PG8_LAS unsigned* flag = (PG8_LAS unsigned*)(lds + 8192 + 2048);
#pragma unroll
        for (int ai = 0; ai < 2; ++ai)
#pragma unroll
            for (int m = 0; m < 4; ++m) {
                float s = 0.f;
#pragma unroll
                for (int bj = 0; bj < 2; ++bj)
#pragma unroll
                    for (int n = 0; n < 2; ++n) { const f32x4 x = v[ai][bj][m][n]; s += (x[0] + x[1]) + (x[2] + x[3]); }
                s += __shfl_xor(s, 16); s += __shfl_xor(s, 32);
                const float mw = s * (1.0f / 64.0f); float q = 0.f;
#pragma unroll
                for (int bj = 0; bj < 2; ++bj)
#pragma unroll
                    for (int n = 0; n < 2; ++n) { const f32x4 d = v[ai][bj][m][n] - mw; q += (d[0] * d[0] + d[1] * d[1]) + (d[2] * d[2] + d[3] * d[3]); }
                q += __shfl_xor(q, 16); q += __shfl_xor(q, 32);
                if (fq == 0) P[(ai * HALF + wr * 64 + m * 16 + fr) * 4 + wc] = (f32x2v){mw, q};
            }
        asm volatile("s_waitcnt lgkmcnt(0)" ::: "memory"); __builtin_amdgcn_s_barrier(); asm volatile("" ::: "memory");
#if defined(BROKEN_NO_WAIT)
        if (blockIdx.x >= 64) { const long long t0 = clock64(); while (clock64() - t0 < 60000) __builtin_amdgcn_s_sleep(8); }
#endif
        const int row = wid * 32 + (lane & 31);
        if (lane < 32) {
            const f32x2v a = P[row * 4 + 0], b = P[row * 4 + 1], c = P[row * 4 + 2], d = P[row * 4 + 3];
            const float mt = (a.x + b.x + c.x + d.x) * 0.25f;
            const float da = a.x - mt, db = b.x - mt, dc = c.x - mt, dd = d.x - mt;
            const float m2 = (a.y + b.y) + (c.y + d.y) + 64.0f * ((da * da + db * db) + (dc * dc + dd * dd));
            unsigned long long* slot = (unsigned long long*)xbuf + ((size_t)(u.pm * BM + row) * 4 + u.pn);
            __hip_atomic_store(slot, ((unsigned long long)__float_as_uint(m2) << 32) | __float_as_uint(mt), __ATOMIC_RELAXED, __HIP_MEMORY_SCOPE_AGENT);
        }
        asm volatile("s_waitcnt vmcnt(0)" ::: "memory");
        if (lane == 0) __hip_atomic_fetch_add(cnt + 64 * u.pm, 1u, __ATOMIC_RELAXED, __HIP_MEMORY_SCOPE_AGENT);
        if (wid == 0) {
            bool dead = false; const unsigned long long t0 = __builtin_amdgcn_s_memrealtime(); const unsigned want = 8u * (unsigned)ntn;
            for (;;) {
#if defined(BROKEN_NO_WAIT)
                break;
#endif
                if ((unsigned)__builtin_amdgcn_readfirstlane(__hip_atomic_load(cnt + 64 * u.pm, __ATOMIC_RELAXED, __HIP_MEMORY_SCOPE_AGENT)) >= want) break;
                if (__builtin_amdgcn_s_memrealtime() - t0 > 2000000ull) {
                    if (lane == 0) { unsigned expect = 0u; __hip_atomic_compare_exchange_strong(tmo + 1, &expect, code | (unsigned)(u.pm & 0xff), __ATOMIC_RELAXED, __ATOMIC_RELAXED, __HIP_MEMORY_SCOPE_AGENT);
                                     __hip_atomic_store(tmo, 1u, __ATOMIC_RELAXED, __HIP_MEMORY_SCOPE_AGENT); }
                    dead = true; break; }
                __builtin_amdgcn_s_sleep(2);
            }
            __builtin_amdgcn_fence(__ATOMIC_ACQUIRE, "agent");
            if (lane == 0) flag[0] = dead ? 1u : 0u;
        }
        asm volatile("s_waitcnt vmcnt(0) lgkmcnt(0)" ::: "memory"); __builtin_amdgcn_s_barrier(); asm volatile("" ::: "memory");
        const bool bad = flag[0] != 0u;
        if (lane < 32) {
            const unsigned long long* slot = (const unsigned long long*)xbuf + (size_t)(u.pm * BM + row) * 4; float mt[4], m2[4]; float ms = 0.f;
#pragma unroll
            for (int t = 0; t < 4; ++t) { if (t < ntn) { const unsigned long long w = __hip_atomic_load(slot + t, __ATOMIC_RELAXED, __HIP_MEMORY_SCOPE_AGENT); mt[t] = __uint_as_float((unsigned)w); m2[t] = __uint_as_float((unsigned)(w >> 32)); } else { mt[t] = 0.f; m2[t] = 0.f; } ms += mt[t]; }
            const float mean = ms / (float)ntn; float q = 0.f;
#pragma unroll
            for (int t = 0; t < 4; ++t) if (t < ntn) { const float dm = mt[t] - mean; q += m2[t] + 256.0f * dm * dm; }
            S[row] = (f32x2v){mean, 1.0f / sqrtf(q / (256.0f * (float)ntn) + eps)};
        }
        asm volatile("s_waitcnt lgkmcnt(0)" ::: "memory"); __builtin_amdgcn_s_barrier(); asm volatile("" ::: "memory");
        return bad;
    }
};
struct EpiLnRes {
    static constexpr bool PERM = false, AFTER_DRAIN = true;
    const float* base; float* out; int ldc; const float* bias; PanelStats st; unsigned poison;
    __device__ __forceinline__ void refuse(size_t i0, size_t stride, int M, int N) const { const float q = __builtin_nanf(""); for (size_t i = i0; i < (size_t)M * N; i += stride) out[(i / N) * ldc + i % N] = q;
        if (i0 == 0) { unsigned expect = 0u; __hip_atomic_compare_exchange_strong(st.tmo + 1, &expect, 0x7f0u, __ATOMIC_RELAXED, __ATOMIC_RELAXED, __HIP_MEMORY_SCOPE_AGENT); __hip_atomic_store(st.tmo, 1u, __ATOMIC_RELAXED, __HIP_MEMORY_SCOPE_AGENT); } }
    __device__ __forceinline__ void fused(f32x4 (&acc)[2][2][4][2], const Unit& u, int wr, int wc, int fr, int fq, PG8_LAS unsigned char* lds, int wid, int lane) const {
        typedef float f32x2v __attribute__((ext_vector_type(2)));
        const PG8_LAS f32x2v* S = (const PG8_LAS f32x2v*)(lds + 8192);
        const int col0 = u.pn * BM + wc * 32 + 4 * fq;
#pragma unroll
        for (int bj = 0; bj < 2; ++bj)
#pragma unroll
            for (int n = 0; n < 2; ++n) { const f32x4 bv = bias ? *(const f32x4*)(bias + col0 + bj * HALF + n * 16) : (f32x4){0.f, 0.f, 0.f, 0.f};
#pragma unroll
                for (int ai = 0; ai < 2; ++ai)
#pragma unroll
                    for (int m = 0; m < 4; ++m) acc[ai][bj][m][n] += bv; }
        const bool bad = st.run(acc, u, wr, wc, fr, fq, lds, wid, lane) || poison != 0u;
        const float qnan = __builtin_nanf("");
#pragma unroll
        for (int ai = 0; ai < 2; ++ai)
#pragma unroll
            for (int m = 0; m < 4; ++m) { const int r = ai * HALF + wr * 64 + m * 16 + fr; const f32x2v sr = S[r]; const size_t off = (size_t)(u.pm * BM + r) * ldc + col0;
#pragma unroll
                for (int bj = 0; bj < 2; ++bj)
#pragma unroll
                    for (int n = 0; n < 2; ++n) { const f32x4 bs = *(const f32x4*)(base + off + bj * HALF + n * 16); f32x4 o = bs + (acc[ai][bj][m][n] - sr.x) * sr.y;
                        if (bad) o = (f32x4){qnan, qnan, qnan, qnan}; *(f32x4*)(out + off + bj * HALF + n * 16) = o; }
                asm volatile("" ::: "memory"); }
    }
};
struct EpiLnResLn {
    static constexpr bool PERM = false, AFTER_DRAIN = true;
    const float* base; float* out; bf16_t* xn; int ldc; const float* bias; PanelStats st1, st2; unsigned poison;
    __device__ __forceinline__ void refuse(size_t i0, size_t stride, int M, int N) const { const float q = __builtin_nanf(""); for (size_t i = i0; i < (size_t)M * N; i += stride) { const size_t o = (i / N) * ldc + i % N; out[o] = q; xn[o] = (bf16_t)0x7fc0u; }
        if (i0 == 0) { unsigned expect = 0u; __hip_atomic_compare_exchange_strong(st1.tmo + 1, &expect, 0x7f0u, __ATOMIC_RELAXED, __ATOMIC_RELAXED, __HIP_MEMORY_SCOPE_AGENT); __hip_atomic_store(st1.tmo, 1u, __ATOMIC_RELAXED, __HIP_MEMORY_SCOPE_AGENT); } }
    __device__ __forceinline__ void fused(f32x4 (&acc)[2][2][4][2], const Unit& u, int wr, int wc, int fr, int fq, PG8_LAS unsigned char* lds, int wid, int lane) const {
        typedef float f32x2v __attribute__((ext_vector_type(2))); typedef unsigned u32x2v __attribute__((ext_vector_type(2)));
        const PG8_LAS f32x2v* S = (const PG8_LAS f32x2v*)(lds + 8192);
        const int col0 = u.pn * BM + wc * 32 + 4 * fq;
#pragma unroll
        for (int bj = 0; bj < 2; ++bj)
#pragma unroll
            for (int n = 0; n < 2; ++n) { const f32x4 bv = bias ? *(const f32x4*)(bias + col0 + bj * HALF + n * 16) : (f32x4){0.f, 0.f, 0.f, 0.f};
#pragma unroll
                for (int ai = 0; ai < 2; ++ai)
#pragma unroll
                    for (int m = 0; m < 4; ++m) acc[ai][bj][m][n] += bv; }
        bool bad = st1.run(acc, u, wr, wc, fr, fq, lds, wid, lane) || poison != 0u;
        const float qnan = __builtin_nanf("");
#pragma unroll
        for (int ai = 0; ai < 2; ++ai)
#pragma unroll
            for (int m = 0; m < 4; ++m) { const int r = ai * HALF + wr * 64 + m * 16 + fr; const f32x2v sr = S[r]; const size_t off = (size_t)(u.pm * BM + r) * ldc + col0;
#pragma unroll
                for (int bj = 0; bj < 2; ++bj)
#pragma unroll
                    for (int n = 0; n < 2; ++n) { const f32x4 bs = *(const f32x4*)(base + off + bj * HALF + n * 16); acc[ai][bj][m][n] = bs + (acc[ai][bj][m][n] - sr.x) * sr.y; }
                asm volatile("" : "+v"(acc[ai][0][m][0]), "+v"(acc[ai][0][m][1]), "+v"(acc[ai][1][m][0]), "+v"(acc[ai][1][m][1]));
                if (m & 1) asm volatile("" ::: "memory"); }
        const bool bad1 = bad;
        bad = st2.run(acc, u, wr, wc, fr, fq, lds, wid, lane) || bad;
#pragma unroll
        for (int ai = 0; ai < 2; ++ai)
#pragma unroll
            for (int m = 0; m < 4; ++m) { const int r = ai * HALF + wr * 64 + m * 16 + fr; const f32x2v sr = S[r]; const size_t off = (size_t)(u.pm * BM + r) * ldc + col0;
#pragma unroll
                for (int bj = 0; bj < 2; ++bj)
#pragma unroll
                    for (int n = 0; n < 2; ++n) { const f32x4 x1 = acc[ai][bj][m][n]; *(f32x4*)(out + off + bj * HALF + n * 16) = bad1 ? (f32x4){qnan, qnan, qnan, qnan} : x1;
                        const f32x4 o = (x1 - sr.x) * sr.y; u32x2v w; w.x = cvt_pk_bf16(o[0], o[1]); w.y = cvt_pk_bf16(o[2], o[3]);
                        if (bad) { w.x = 0x7fc07fc0u; w.y = 0x7fc07fc0u; } *(u32x2v*)(xn + off + bj * HALF + n * 16) = w; }
                asm volatile("" ::: "memory"); }
    }
};

template <class Epi, class Sched, bool STAMP = false>
__device__ __forceinline__ void gemm_phase(PG8_LAS unsigned char* lds, const Gemm g, const Sched& S, const Epi& E, unsigned long long* stamps) {
    int tid_ = threadIdx.x; asm volatile("" : "+v"(tid_));
    const int tid = tid_, wid = __builtin_amdgcn_readfirstlane(tid >> 6), lane = tid & 63, wr = wid >> 2, wc = wid & 3, fr = lane & 15, fq = lane >> 4;
    const int K = g.K, nt = K / BK;
    int ts_lo = 0, ts_hi = 0, nts = 0; const unsigned long long rt_entry = STAMP ? (unsigned long long)wall_clock64() : 0ull;
#define PG8_STAMP() do { if (STAMP && wid == 0 && nts < 64) { const unsigned long long _c = (unsigned long long)clock64(); \
        ts_lo = (lane == nts) ? (int)(unsigned)_c : ts_lo; ts_hi = (lane == nts) ? (int)(unsigned)(_c >> 32) : ts_hi; ++nts; } } while (0)
    PG8_STAMP();
    unsigned voffA[2], voffB[2];
#pragma unroll
    for (int i = 0; i < 2; ++i) { int R, C; stage_rc(tid * 16 + i * 8192, R, C); const int Rb = Epi::PERM ? ((R & ~31) + perm32(R & 31)) : R;
        voffA[i] = (unsigned)(R * K + C) * 2u; voffB[i] = (unsigned)(Rb * K + C) * 2u; }
    const size_t kstep = (size_t)(BK * 2);
    const size_t hstep = (size_t)HALF * K * 2;
    const size_t tstep = 2 * hstep;
    const unsigned ldsw = (unsigned)wid * 1024u;
    const int aoff = lds_byte(wr * 64 + fr, fq * 8), boff = lds_byte(wc * 32 + fr, fq * 8);
#define PG8_SA(b, h) (((b) * 2 + (h)) * HTB)
#define PG8_SB(b, h) ((4 + (b) * 2 + (h)) * HTB)
#define PG8_STAGE(bufoff, gbase, voff) do { _Pragma("unroll") for (int _i = 0; _i < 2; ++_i) \
        __builtin_amdgcn_global_load_lds((const unsigned*)((const char*)(gbase) + (voff)[_i]), (PG8_LAS unsigned*)(lds + (bufoff) + ldsw + _i * 8192), 16, 0, 0); } while (0)
#define PG8_LDA(dst, b, h) do { _Pragma("unroll") for (int m = 0; m < 4; ++m) _Pragma("unroll") for (int k = 0; k < 2; ++k) dst[m][k] = *(const PG8_LAS bf16x8*)(lds + PG8_SA(b, h) + aoff + m * 2048 + k * 1024); } while (0)
#define PG8_LDB(dst, b, h) do { _Pragma("unroll") for (int n = 0; n < 2; ++n) _Pragma("unroll") for (int k = 0; k < 2; ++k) dst[n][k] = *(const PG8_LAS bf16x8*)(lds + PG8_SB(b, h) + boff + n * 2048 + k * 1024); } while (0)
#define PG8_MMA(ai, bj, At, Bt) do { __builtin_amdgcn_s_setprio(1); _Pragma("unroll") for (int m = 0; m < 4; ++m) _Pragma("unroll") for (int n = 0; n < 2; ++n) _Pragma("unroll") for (int k = 0; k < 2; ++k) \
        acc[ai][bj][m][n] = __builtin_amdgcn_mfma_f32_16x16x32_bf16(Bt[n][k], At[m][k], acc[ai][bj][m][n], 0, 0, 0); __builtin_amdgcn_s_setprio(0); } while (0)
#define PG8_WAIT_V(n) asm volatile("s_waitcnt vmcnt(" #n ")" ::: "memory")
#define PG8_WAIT_L(n) asm volatile("s_waitcnt lgkmcnt(" #n ")" ::: "memory")
#define PG8_BAR __builtin_amdgcn_s_barrier()
#define PG8_SCHED __builtin_amdgcn_sched_barrier(0)
    Unit cur, nxt; int ui = 0;
    if (!S.next(0, cur)) return;
    f32x4 acc[2][2][4][2];
#pragma unroll
    for (int a = 0; a < 2; ++a)
#pragma unroll
        for (int b = 0; b < 2; ++b)
#pragma unroll
            for (int m = 0; m < 4; ++m)
#pragma unroll
                for (int n = 0; n < 2; ++n) acc[a][b][m][n] = (f32x4){0.f, 0.f, 0.f, 0.f};
    bf16x8 At[4][2], B0[2][2], B1[2][2];
    const char* cA = (const char*)g.A + (size_t)cur.pm * tstep; const char* cB = (const char*)g.Bt + (size_t)cur.pn * tstep;
    S.a_ready(cur);
    PG8_STAGE(PG8_SB(0, 0), cB, voffB); PG8_STAGE(PG8_SA(0, 0), cA, voffA); PG8_STAGE(PG8_SB(0, 1), cB + hstep, voffB); PG8_STAGE(PG8_SA(0, 1), cA + hstep, voffA);
    if (wr == 1) PG8_BAR;
    PG8_WAIT_V(4); PG8_BAR;
    PG8_STAGE(PG8_SB(1, 0), cB + kstep, voffB); PG8_STAGE(PG8_SA(1, 0), cA + kstep, voffA); PG8_STAGE(PG8_SB(1, 1), cB + hstep + kstep, voffB);
    PG8_WAIT_V(6); PG8_BAR;
    PG8_STAMP();
    for (;;) {
        const bool has_next = S.next(ui + 1, nxt);
        const char* nA = has_next ? (const char*)g.A + (size_t)nxt.pm * tstep : cA; const char* nB = has_next ? (const char*)g.Bt + (size_t)nxt.pn * tstep : cB;
        for (int t = 0; t < nt; t += 2) {
            const bool last = (t == nt - 2);
            const char* a1 = cA + (size_t)(t + 1) * kstep;
            const char* a2 = last ? nA : cA + (size_t)(t + 2) * kstep; const char* b2 = last ? nB : cB + (size_t)(t + 2) * kstep;
            const char* a3 = a2 + kstep; const char* b3 = b2 + kstep;
            if (last && has_next) S.a_ready(nxt);
            PG8_LDB(B0, 0, 0); PG8_SCHED; PG8_LDA(At, 0, 0); PG8_STAGE(PG8_SA(1, 1), a1 + hstep, voffA);
            PG8_WAIT_L(8); PG8_BAR; PG8_WAIT_L(0); PG8_MMA(0, 0, At, B0); PG8_BAR; PG8_SCHED;
            PG8_LDB(B1, 0, 1); PG8_STAGE(PG8_SB(0, 0), b2, voffB);
            PG8_BAR; PG8_WAIT_L(0); PG8_MMA(0, 1, At, B1); PG8_BAR;
            PG8_LDA(At, 0, 1); PG8_STAGE(PG8_SA(0, 0), a2, voffA);
            PG8_BAR; PG8_WAIT_L(0); PG8_MMA(1, 0, At, B0); PG8_BAR; PG8_SCHED;
            PG8_STAGE(PG8_SB(0, 1), b2 + hstep, voffB);
            PG8_WAIT_V(6); PG8_BAR; PG8_MMA(1, 1, At, B1); PG8_BAR;
            PG8_LDB(B0, 1, 0); PG8_SCHED; PG8_LDA(At, 1, 0); PG8_STAGE(PG8_SA(0, 1), a2 + hstep, voffA);
            PG8_WAIT_L(8); PG8_BAR; PG8_WAIT_L(0); PG8_MMA(0, 0, At, B0); PG8_BAR; PG8_SCHED;
            PG8_LDB(B1, 1, 1); PG8_STAGE(PG8_SB(1, 0), b3, voffB);
            PG8_BAR; PG8_WAIT_L(0); PG8_MMA(0, 1, At, B1); PG8_BAR;
            PG8_LDA(At, 1, 1); PG8_STAGE(PG8_SA(1, 0), a3, voffA);
            PG8_BAR; PG8_WAIT_L(0); PG8_MMA(1, 0, At, B0); PG8_BAR; PG8_SCHED;
            PG8_STAGE(PG8_SB(1, 1), b3 + hstep, voffB);
            PG8_WAIT_V(6); PG8_BAR; PG8_MMA(1, 1, At, B1); PG8_BAR;
        }
        PG8_STAMP();
        if constexpr (!Epi::AFTER_DRAIN) { E(acc, cur, wr, wc, fr, fq); S.done(cur); }
        PG8_STAMP();
        if (!has_next) break;
#pragma unroll
        for (int a = 0; a < 2; ++a)
#pragma unroll
            for (int b = 0; b < 2; ++b)
#pragma unroll
                for (int m = 0; m < 4; ++m)
#pragma unroll
                    for (int n = 0; n < 2; ++n) acc[a][b][m][n] = (f32x4){0.f, 0.f, 0.f, 0.f};
        cur = nxt; cA = nA; cB = nB; ++ui;
    }
    PG8_WAIT_V(0);
    if (wr == 0) PG8_BAR;
    PG8_BAR;
    if constexpr (Epi::AFTER_DRAIN) { E.fused(acc, cur, wr, wc, fr, fq, lds, wid, lane); S.done(cur); }
    PG8_STAMP();
    if (STAMP && wid == 0) { stamps[lane] = lane < nts ? (((unsigned long long)(unsigned)ts_hi << 32) | (unsigned)ts_lo) : 0ull;
        if (lane == 62) stamps[62] = rt_entry; if (lane == 63) stamps[63] = (unsigned long long)wall_clock64(); }
#undef PG8_STAMP
#undef PG8_SA
#undef PG8_SB
#undef PG8_STAGE
#undef PG8_LDA
#undef PG8_LDB
#undef PG8_MMA
#undef PG8_WAIT_V
#undef PG8_WAIT_L
#undef PG8_BAR
#undef PG8_SCHED
}
}
#define XB_TMO      128
#define XB_XCNT(j)  (256  + 64 * (j))
#define XB_XSUB(j)  (1280 + 64 * (j))
#define XB_XGEN(j)  (2304 + 64 * (j))
#define XB_TOP      3328
#define XB_TOPGEN   3392
#define XCD_BAR_WORDS 3456
#define XB_SPIN_CAP (1u << 18)
#define LAS __attribute__((address_space(3)))

__device__ __forceinline__ unsigned xb_ld(unsigned* p)              { return __hip_atomic_load(p, __ATOMIC_RELAXED, __HIP_MEMORY_SCOPE_AGENT); }
__device__ __forceinline__ unsigned xb_add(unsigned* p, unsigned v) { return __hip_atomic_fetch_add(p, v, __ATOMIC_RELAXED, __HIP_MEMORY_SCOPE_AGENT); }
__device__ __forceinline__ unsigned xb_xcc_id() { return (unsigned)__builtin_amdgcn_s_getreg((3 << 11) | 20) & 0xFu; }
#define XB_SPIN(cond, bar) do { unsigned _sp = 0; while (cond) { __builtin_amdgcn_s_sleep(1); \
    if ((++_sp & 255u) == 0u) { if (xb_ld(&(bar)[XB_TMO])) break; if (_sp > XB_SPIN_CAP) { atomicAdd(&(bar)[XB_TMO], 1u); break; } } } } while (0)

struct XcdBarrier {
    unsigned* bar; unsigned x;
    volatile LAS unsigned* st;
};

__device__ __forceinline__ XcdBarrier xcd_barrier_post(unsigned* bar, volatile LAS unsigned* st) {
    XcdBarrier b; b.bar = bar; b.x = xb_xcc_id(); b.st = st;
    if (threadIdx.x == 0) (void)xb_add(&bar[XB_XCNT(b.x)], 1u);
    return b;
}
__device__ __forceinline__ void xcd_barrier_complete(unsigned* bar, unsigned x, unsigned& nloc, unsigned& nx) {
    const unsigned G = gridDim.x * gridDim.y * gridDim.z;
    unsigned sum, cnt, mine, sp = 0u;
    for (;;) {
        sum = 0u; cnt = 0u; mine = 0u;
#pragma unroll
        for (unsigned j = 0; j < 16; ++j) { const unsigned c = xb_ld(&bar[XB_XCNT(j)]); sum += c; cnt += (c > 0u) ? 1u : 0u; mine = (j == x) ? c : mine; }
        if (sum == G) break;
        __builtin_amdgcn_s_sleep(1);
        if ((++sp & 255u) == 0u) { if (xb_ld(&bar[XB_TMO])) break; if (sp > XB_SPIN_CAP) { atomicAdd(&bar[XB_TMO], 1u); break; } }
    }
    nloc = mine > 0u ? mine : 1u; nx = cnt > 0u ? cnt : 1u;
}

__device__ __forceinline__ void xcd_barrier(const XcdBarrier& b) {
    asm volatile("s_waitcnt vmcnt(0)" ::: "memory");
    __syncthreads();
    if (threadIdx.x == 0) {
        unsigned* bar = b.bar;
        __builtin_amdgcn_s_waitcnt(0);
        unsigned nloc = b.st[0], nx = b.st[1];
        if (nloc == 0u) { xcd_barrier_complete(bar, b.x, nloc, nx); b.st[0] = nloc; b.st[1] = nx; }
        const unsigned old = xb_add(&bar[XB_XSUB(b.x)], 1u);
        const unsigned gen = old / nloc;
        if (old + 1u == (gen + 1u) * nloc) {
            __builtin_amdgcn_fence(__ATOMIC_RELEASE, "agent");
            asm volatile("s_waitcnt vmcnt(0)" ::: "memory");
            const unsigned og = xb_add(&bar[XB_TOP], 1u);
            const unsigned tg = og / nx;
            if (og + 1u == (tg + 1u) * nx) xb_add(&bar[XB_TOPGEN], 1u);
            else XB_SPIN(xb_ld(&bar[XB_TOPGEN]) == tg, bar);
            __builtin_amdgcn_fence(__ATOMIC_ACQUIRE, "agent");
            xb_add(&bar[XB_XGEN(b.x)], 1u);
            asm volatile("s_waitcnt vmcnt(0)" ::: "memory");
        } else {
            XB_SPIN(xb_ld(&bar[XB_XGEN(b.x)]) == gen, bar);
            __builtin_amdgcn_fence(__ATOMIC_ACQUIRE, "agent");
            asm volatile("s_waitcnt vmcnt(0)" ::: "memory");
        }
    }
    __syncthreads();
}

namespace mk {
typedef unsigned short bf16;
typedef unsigned v4u __attribute__((ext_vector_type(4)));
typedef unsigned v2u __attribute__((ext_vector_type(2)));
typedef float f32x4 __attribute__((ext_vector_type(4)));
typedef float f32x2 __attribute__((ext_vector_type(2)));

constexpr int S = 8192, D = 2048, NL = 4, NADA = 6 * D;
constexpr int NIN = 10776, ZLD = 11008, NUP = 11264, DFF = 5632;
constexpr int ZQ = 0, ZKC = 1024, ZVC = 1280, ZKS = 1536, ZVS = 1792, ZKW = 2048, ZVW = 2304, ZAG = 2560, ZQH = 2584, ZFH = 3608, ZIH = 4632, ZOG = 5656, ZMG = 6680;
constexpr int NCMP = 511, NSEL = 128, TOPK = 16, WINDOW = 512;
constexpr int HGC = 64, HGNC = S / HGC;
constexpr float EPS = 1e-6f;
constexpr float QSCALE = 0.08838834764831845f;
constexpr int KSPLIT = 8;

constexpr size_t MiB = 1u << 20;
constexpr size_t WS_CTL = 0, CTL_ZERO_BYTES = 1 * MiB;
constexpr size_t WS_ADAP = 1 * MiB;
constexpr size_t WS_ADA = 3 * MiB;
constexpr size_t WS_LB = 3 * MiB + 256 * 1024;
constexpr size_t WS_ROPE = 4 * MiB;
constexpr size_t WS_KCMP = 8 * MiB;
constexpr size_t WS_VCMP = 8 * MiB + 512 * 1024;
constexpr size_t WS_HGD = 9 * MiB;
constexpr size_t WS_WIN = 16 * MiB;
constexpr size_t WS_WUP = 188 * MiB;
constexpr size_t WS_WDN = 364 * MiB;
constexpr size_t WS_WOUT = 452 * MiB;
constexpr size_t WS_WBA = 484 * MiB;
constexpr size_t WS_WBH = 500 * MiB;
constexpr size_t WS_H = 516 * MiB;
constexpr size_t WS_Z = 548 * MiB;
constexpr size_t WS_ATTN = 724 * MiB;
constexpr size_t WS_HG = 740 * MiB;
constexpr size_t WS_PART = 756 * MiB;
constexpr size_t WS_MIXED = 820 * MiB;
constexpr size_t WS_Y = 852 * MiB;
constexpr size_t WS_G = 916 * MiB;
constexpr size_t WS_HGS = 1004 * MiB;
constexpr size_t WS_END = 1068 * MiB;
constexpr int CW_BAR = 4096;

constexpr int RING_BYTES = 131072, LDS_BYTES = 147456, LDSCTL_OFF = LDS_BYTES - 512;

#define LDS_WAIT() asm volatile("s_waitcnt lgkmcnt(0)" ::: "memory")

__device__ __forceinline__ float bf2f(unsigned v) { return __uint_as_float(v << 16); }
__device__ __forceinline__ float bflo(unsigned w) { return __uint_as_float(w << 16); }
__device__ __forceinline__ float bfhi(unsigned w) { return __uint_as_float(w & 0xffff0000u); }
__device__ __forceinline__ unsigned f2bf(float f) { unsigned u = __float_as_uint(f); return (u + 0x7fffu + ((u >> 16) & 1u)) >> 16; }
__device__ __forceinline__ unsigned pk2(float lo, float hi) { return f2bf(lo) | (f2bf(hi) << 16); }
__device__ __forceinline__ float wave_sum(float v) {
#pragma unroll
    for (int o = 1; o < 64; o <<= 1) v += __shfl_xor(v, o);
    return v;
}
__device__ __forceinline__ float wave_max(float v) {
#pragma unroll
    for (int o = 1; o < 64; o <<= 1) v = fmaxf(v, __shfl_xor(v, o));
    return v;
}
__device__ __forceinline__ float sigmoidf_(float x) { return 1.0f / (1.0f + __expf(-x)); }
__device__ __forceinline__ float siluf_(float x) { return x / (1.0f + __expf(-x)); }

struct Args { const float* in[23]; float* out; unsigned char* ws; int ph_lo, ph_hi; };

struct Frame {
    LAS unsigned char* lds;
    int tid, lane, wave, G, bid;
    unsigned char* ws;
    float* out;
};
__device__ __forceinline__ const float* inp(const Frame& F, int k) {
    const unsigned long long v = ((const LAS unsigned long long*)(F.lds + LDSCTL_OFF + 128))[k];
    const unsigned lo = __builtin_amdgcn_readfirstlane((unsigned)v), hi = __builtin_amdgcn_readfirstlane((unsigned)(v >> 32));
    return (const float*)(((unsigned long long)hi << 32) | lo);
}

__device__ __forceinline__ void tr_item(const float* W, int K, int N, int Npad, bf16* WT, LAS float* scr, int item, int lane) {
    const int nblk = Npad / 32, kb = item / nblk, nb = item % nblk, k0 = 64 * kb, n0 = 32 * nb;
    const int nn = n0 + (lane & 31);
#pragma unroll 8
    for (int i = 0; i < 32; ++i) { const int kk = 2 * i + (lane >> 5); scr[kk * 33 + (lane & 31)] = (nn < N) ? W[(size_t)(k0 + kk) * N + nn] : 0.f; }
    LDS_WAIT(); asm volatile("" ::: "memory");
    const int c = lane & 7;
#pragma unroll
    for (int j = 0; j < 4; ++j) { const int n = (lane >> 3) + 8 * j; const LAS float* s = scr + (8 * c) * 33 + n;
        v4u o; o.x = pk2(s[0 * 33], s[1 * 33]); o.y = pk2(s[2 * 33], s[3 * 33]); o.z = pk2(s[4 * 33], s[5 * 33]); o.w = pk2(s[6 * 33], s[7 * 33]);
        *(v4u*)(WT + (size_t)(n0 + n) * K + k0 + 8 * c) = o; }
    LDS_WAIT(); asm volatile("" ::: "memory");
}

__device__ __forceinline__ void p0_prologue(Frame& F) {
    const int gtid = F.bid * 512 + F.tid, NT = F.G * 512;
    {
        LAS float* cact = (LAS float*)F.lds;
        for (int k = F.tid; k < D; k += 512) cact[k] = siluf_(inp(F, 1)[k]);
        __syncthreads();
        const float* w_ada = inp(F, 3);
        float* part = (float*)(F.ws + WS_ADAP);
        for (int idx = gtid; idx < KSPLIT * NL * (NADA / 4); idx += NT) {
            const int ks = idx / (NL * (NADA / 4)), rem = idx % (NL * (NADA / 4)), l = rem / (NADA / 4), col = 4 * (rem % (NADA / 4));
            const float* wp = w_ada + ((size_t)l * D + (size_t)ks * (D / KSPLIT)) * NADA + col;
            f32x4 acc = {0.f, 0.f, 0.f, 0.f};
#pragma unroll 8
            for (int k = 0; k < D / KSPLIT; ++k) { const f32x4 w = *(const f32x4*)(wp + (size_t)k * NADA); acc += w * cact[ks * (D / KSPLIT) + k]; }
            *(f32x4*)(part + (size_t)(ks * NL + l) * NADA + col) = acc;
        }
        __syncthreads();
    }
    {
        float* ct = (float*)(F.ws + WS_ROPE); float* st = ct + (size_t)S * 64;
        const int* pos = (const int*)inp(F, 2);
        for (int idx = gtid; idx < S * 64; idx += NT) {
            const int t = idx >> 6, i = idx & 63;
            const float invf = 1.0f / __builtin_powf(10000.0f, (float)(2 * i) / 128.0f);
            const float angf = (float)pos[t] * invf;
            const double a = (double)angf;
            const double q = __builtin_rint(a * 0.63661977236758134308);
            const double r = (a - q * 1.57079632679489655800) - q * 6.12323399573676603587e-17;
            const double r2 = r * r;
            double sp = -2.50521083854417187751e-08; sp = sp * r2 + 2.75573192239858906526e-06; sp = sp * r2 - 1.98412698412698412698e-04; sp = sp * r2 + 8.33333333333333333333e-03; sp = sp * r2 - 1.66666666666666666667e-01;
            const double sr = r + r * r2 * sp;
            double cp = 2.08767569878680989792e-09; cp = cp * r2 - 2.75573192239858906526e-07; cp = cp * r2 + 2.48015873015873015873e-05; cp = cp * r2 - 1.38888888888888888889e-03; cp = cp * r2 + 4.16666666666666666667e-02; cp = cp * r2 - 0.5;
            const double cr = 1.0 + r2 * cp;
            const int qi = ((int)(long long)q) & 3;
            const double sv = (qi == 0) ? sr : (qi == 1) ? cr : (qi == 2) ? -sr : -cr;
            const double cv = (qi == 0) ? cr : (qi == 1) ? -sr : (qi == 2) ? -cr : sr;
            ct[idx] = (float)cv; st[idx] = (float)sv;
        }
    }
    {
        float* lb = (float*)(F.ws + WS_LB); const float* lg = inp(F, 11);
        for (int c = gtid; c < 1024; c += NT) {
            float v[NL], m = -1e30f;
#pragma unroll
            for (int l = 0; l < NL; ++l) { v[l] = lg[l * 1024 + c]; m = fmaxf(m, v[l]); }
            float s = 0.f;
#pragma unroll
            for (int l = 0; l < NL; ++l) { v[l] = expf(v[l] - m); s += v[l]; }
            float run = 0.f;
#pragma unroll
            for (int l = 0; l < NL; ++l) { lb[l * 1024 + c] = run; if (l + 1 < NL) run += v[l + 1] / s; }
        }
    }
    {
        LAS float* scr = (LAS float*)(F.lds + 16384 + F.wave * 12288);
        const int gw = F.bid * 8 + F.wave, NGW = F.G * 8;
        constexpr int I_IN = (D / 64) * (ZLD / 32), I_UP = (D / 64) * (NUP / 32), I_DN = (DFF / 64) * (D / 32), I_OUT = (D / 64) * (D / 32), I_BR = (1024 / 64) * (D / 32);
        constexpr int I_LAYER = I_IN + I_UP + I_DN + I_OUT + 2 * I_BR;
        for (int it = gw; it < NL * I_LAYER; it += NGW) {
            const int l = it / I_LAYER; int r = it % I_LAYER;
            if (r < I_IN) { tr_item(inp(F, 6) + (size_t)l * D * NIN, D, NIN, ZLD, (bf16*)(F.ws + WS_WIN) + (size_t)l * ZLD * D, scr, r, F.lane); continue; } r -= I_IN;
            if (r < I_UP) { tr_item(inp(F, 18) + (size_t)l * D * NUP, D, NUP, NUP, (bf16*)(F.ws + WS_WUP) + (size_t)l * NUP * D, scr, r, F.lane); continue; } r -= I_UP;
            if (r < I_DN) { tr_item(inp(F, 21) + (size_t)l * DFF * D, DFF, D, D, (bf16*)(F.ws + WS_WDN) + (size_t)l * D * DFF, scr, r, F.lane); continue; } r -= I_DN;
            if (r < I_OUT) { tr_item(inp(F, 15) + (size_t)l * D * D, D, D, D, (bf16*)(F.ws + WS_WOUT) + (size_t)l * D * D, scr, r, F.lane); continue; } r -= I_OUT;
            if (r < I_BR) { tr_item(inp(F, 13) + (size_t)l * 1024 * D, 1024, D, D, (bf16*)(F.ws + WS_WBA) + (size_t)l * D * 1024, scr, r, F.lane); continue; } r -= I_BR;
            tr_item(inp(F, 14) + (size_t)l * 1024 * D, 1024, D, D, (bf16*)(F.ws + WS_WBH) + (size_t)l * D * 1024, scr, r, F.lane);
        }
    }
}
__device__ __forceinline__ void p0b_ada(Frame& F) {
    const int gtid = F.bid * 512 + F.tid, NT = F.G * 512;
    const float* part = (const float*)(F.ws + WS_ADAP); float* ada = (float*)(F.ws + WS_ADA);
    for (int j = gtid; j < NL * NADA; j += NT) { float s = inp(F, 4)[j];
#pragma unroll
        for (int ks = 0; ks < KSPLIT; ++ks) s += part[(size_t)ks * NL * NADA + j];
        ada[j] = s; }
}

template <bool POST, bool PRE>
__device__ __forceinline__ void row_phase(Frame& F, const float* xin, const float* y, float* xout, bf16* h,
                                          const float* gpost, const float* gt, const float* gpre, const float* sc, const float* sh) {
    const int gw = F.bid * 8 + F.wave, NGW = F.G * 8, lane = F.lane;
    for (int row = gw; row < S; row += NGW) {
        f32x4 x[8];
#pragma unroll
        for (int j = 0; j < 8; ++j) x[j] = *(const f32x4*)(xin + (size_t)row * D + 4 * lane + 256 * j);
        if (POST) {
            f32x4 yv[8]; float ss = 0.f;
#pragma unroll
            for (int j = 0; j < 8; ++j) { yv[j] = *(const f32x4*)(y + (size_t)row * D + 4 * lane + 256 * j); ss += (yv[j].x * yv[j].x + yv[j].y * yv[j].y) + (yv[j].z * yv[j].z + yv[j].w * yv[j].w); }
            const float r1 = 1.0f / sqrtf(wave_sum(ss) * (1.0f / D) + EPS);
#pragma unroll
            for (int j = 0; j < 8; ++j) { const f32x4 g = *(const f32x4*)(gpost + 4 * lane + 256 * j), a = *(const f32x4*)(gt + 4 * lane + 256 * j);
                x[j] = x[j] + a * ((yv[j] * r1) * g); *(f32x4*)(xout + (size_t)row * D + 4 * lane + 256 * j) = x[j]; }
        }
        if (PRE) {
            float ss = 0.f;
#pragma unroll
            for (int j = 0; j < 8; ++j) ss += (x[j].x * x[j].x + x[j].y * x[j].y) + (x[j].z * x[j].z + x[j].w * x[j].w);
            const float r2 = 1.0f / sqrtf(wave_sum(ss) * (1.0f / D) + EPS);
#pragma unroll
            for (int j = 0; j < 8; ++j) { const f32x4 g = *(const f32x4*)(gpre + 4 * lane + 256 * j), a = *(const f32x4*)(sc + 4 * lane + 256 * j), b = *(const f32x4*)(sh + 4 * lane + 256 * j);
                const f32x4 o = ((x[j] * r2) * g) * (a + 1.0f) + b;
                v2u w; w.x = pk2(o.x, o.y); w.y = pk2(o.z, o.w);
                *(v2u*)(h + (size_t)row * D + 4 * lane + 256 * j) = w; }
        }
    }
}

__device__ __forceinline__ float log_f_of(float x, float lb) {
    const float ls = fminf(x, 0.f) - log1pf(expf(-fabsf(x)));
    return (lb > 0.f) ? logf(lb + (1.f - lb) * expf(ls)) : ls;
}

__device__ __forceinline__ void phase_c(Frame& F, int l) {
    const int gtid = F.bid * 512 + F.tid, NT = F.G * 512, lane = F.lane;
    bf16* z = (bf16*)(F.ws + WS_Z);
    const float* ct = (const float*)(F.ws + WS_ROPE); const float* st = ct + (size_t)S * 64;
    {
        LAS float* A = (LAS float*)(F.lds + F.wave * 8192);
        const int gw = F.bid * 8 + F.wave, NGW = F.G * 8;
        bf16* kcmp = (bf16*)(F.ws + WS_KCMP); bf16* vcmp = (bf16*)(F.ws + WS_VCMP);
        for (int it = gw; it < NCMP * 2; it += NGW) {
            const int n = it >> 1, kv = it & 1;
            const float* pe = (kv ? inp(F, 9) : inp(F, 7)) + (size_t)l * 32 * 128;
            const float* w = (kv ? inp(F, 10) : inp(F, 8)) + (size_t)l * 4096 * 128;
            float a00 = 0.f, a01 = 0.f, a10 = 0.f, a11 = 0.f;
            for (int q = 0; q < 4; ++q) {
#pragma unroll 4
                for (int itr = 0; itr < 16; ++itr) {
                    const int i = lane + 64 * itr, g = i >> 9, pp = (i >> 6) & 7, d = i & 63;
                    const int tok = 16 * n + 8 * q + pp;
                    const bf16* zr = z + (size_t)tok * ZLD + (kv ? ZVC : ZKC) + g * 128;
                    const float x1 = bf2f(zr[d]), x2 = bf2f(zr[d + 64]);
                    const float p1 = pe[(8 * q + pp) * 128 + d], p2 = pe[(8 * q + pp) * 128 + d + 64];
                    float o1, o2;
                    if (kv == 0) { const float cs = ct[(size_t)tok * 64 + d], sn = st[(size_t)tok * 64 + d]; o1 = x1 * cs - x2 * sn; o2 = x2 * cs + x1 * sn; }
                    else { o1 = x1; o2 = x2; }
                    A[g * 1024 + pp * 128 + d] = o1 + p1; A[g * 1024 + pp * 128 + d + 64] = o2 + p2;
                }
                LDS_WAIT(); asm volatile("" ::: "memory");
                const float* wq = w + (size_t)q * 1024 * 128 + 2 * lane;
#pragma unroll 2
                for (int kk = 0; kk < 1024; kk += 4) {
                    const f32x4 av0 = *(const LAS f32x4*)(A + kk), av1 = *(const LAS f32x4*)(A + 1024 + kk);
#pragma unroll
                    for (int e = 0; e < 4; ++e) { const f32x2 wv = *(const f32x2*)(wq + (size_t)(kk + e) * 128);
                        a00 += av0[e] * wv.x; a01 += av0[e] * wv.y; a10 += av1[e] * wv.x; a11 += av1[e] * wv.y; }
                }
                LDS_WAIT(); asm volatile("" ::: "memory");
            }
            bf16* o = kv ? vcmp : kcmp;
            *(unsigned*)(o + (size_t)(n * 2 + 0) * 128 + 2 * lane) = pk2(a00, a01);
            *(unsigned*)(o + (size_t)(n * 2 + 1) * 128 + 2 * lane) = pk2(a10, a11);
        }
    }
    for (int idx = gtid; idx < S * 96; idx += NT) {
        const int t = idx / 96, r = idx % 96, hd = r >> 3, ch = r & 7;
        const int col = hd < 8 ? ZQ + hd * 128 : (hd < 10 ? ZKS + (hd - 8) * 128 : ZKW + (hd - 10) * 128);
        bf16* p1 = z + (size_t)t * ZLD + col + 8 * ch; bf16* p2 = p1 + 64;
        const v4u a = *(const v4u*)p1, b = *(const v4u*)p2;
        const f32x4 c0 = *(const f32x4*)(ct + (size_t)t * 64 + 8 * ch), c1 = *(const f32x4*)(ct + (size_t)t * 64 + 8 * ch + 4);
        const f32x4 s0 = *(const f32x4*)(st + (size_t)t * 64 + 8 * ch), s1 = *(const f32x4*)(st + (size_t)t * 64 + 8 * ch + 4);
        v4u oa, ob;
        const float cs8[8] = {c0.x, c0.y, c0.z, c0.w, c1.x, c1.y, c1.z, c1.w}, sn8[8] = {s0.x, s0.y, s0.z, s0.w, s1.x, s1.y, s1.z, s1.w};
#pragma unroll
        for (int e = 0; e < 4; ++e) {
            const float x1l = bflo(a[e]), x1h = bfhi(a[e]), x2l = bflo(b[e]), x2h = bfhi(b[e]);
            const float cl = cs8[2 * e], chh = cs8[2 * e + 1], sl = sn8[2 * e], shh = sn8[2 * e + 1];
            oa[e] = pk2(x1l * cl - x2l * sl, x1h * chh - x2h * shh);
            ob[e] = pk2(x2l * cl + x1l * sl, x2h * chh + x1h * shh);
        }
        *(v4u*)p1 = oa; *(v4u*)p2 = ob;
    }
    __syncthreads();
    {
        constexpr int LDP = 132;
        LAS float* Bs = (LAS float*)F.lds;
        LAS float* Ks = Bs + 64 * LDP;
        LAS float* Vs = Ks + 64 * LDP;
        const float* lbv = (const float*)(F.ws + WS_LB) + l * 1024;
        float* hgD = (float*)(F.ws + WS_HGD); float* hgS = (float*)(F.ws + WS_HGS);
        for (int it = F.bid; it < HGNC * 8; it += F.G) {
            const int c = it >> 3, h = it & 7;
            for (int i = F.tid; i < 64 * 128; i += 512) { const int t = i >> 7, d = i & 127; const bf16* zr = z + (size_t)(c * HGC + t) * ZLD + h * 128 + d;
                Bs[t * LDP + d] = log_f_of(bf2f(zr[ZFH]), lbv[h * 128 + d]); Vs[t * LDP + d] = bf2f(zr[ZIH]); }
            __syncthreads();
            if (F.tid < 128) { float run = 0.f; const int d = F.tid;
                for (int t = 0; t < 64; ++t) { const float lf = Bs[t * LDP + d]; run += lf; Bs[t * LDP + d] = run; Ks[t * LDP + d] = -expm1f(lf); } }
            __syncthreads();
            for (int i = F.tid; i < 64 * 128; i += 512) { const int t = i >> 7, d = i & 127; Ks[t * LDP + d] *= expf(Bs[63 * LDP + d] - Bs[t * LDP + d]); }
            if (F.tid < 128) hgD[(size_t)it * 128 + F.tid] = expf(Bs[63 * LDP + F.tid]);
            __syncthreads();
            float acc[16][2];
#pragma unroll
            for (int i = 0; i < 16; ++i) { acc[i][0] = 0.f; acc[i][1] = 0.f; }
            const int d0 = 16 * F.wave;
            for (int s = 0; s < 64; ++s) {
                const float v0 = Vs[s * LDP + lane], v1 = Vs[s * LDP + lane + 64];
#pragma unroll
                for (int i4 = 0; i4 < 4; ++i4) { const f32x4 kq = *(const LAS f32x4*)(Ks + s * LDP + d0 + 4 * i4);
#pragma unroll
                    for (int e = 0; e < 4; ++e) { acc[4 * i4 + e][0] += kq[e] * v0; acc[4 * i4 + e][1] += kq[e] * v1; } }
            }
#pragma unroll
            for (int i = 0; i < 16; ++i) { float* o = hgS + ((size_t)it * 128 + d0 + i) * 128; o[lane] = acc[i][0]; o[lane + 64] = acc[i][1]; }
            __syncthreads();
        }
    }
}

__device__ __forceinline__ void hgrn_pass2(Frame& F) {
    const int gtid = F.bid * 512 + F.tid, NT = F.G * 512;
    float* hgS = (float*)(F.ws + WS_HGS); const float* hgD = (const float*)(F.ws + WS_HGD);
    for (int e = gtid; e < 8 * 128 * 128; e += NT) {
        const int hd = e >> 7;
        float st = 0.f;
#pragma unroll 8
        for (int c = 0; c < HGNC; ++c) { float* p = hgS + (size_t)c * 131072 + e; const float u = *p; const float dc = hgD[(size_t)c * 1024 + hd]; *p = st; st = dc * st + u; }
    }
}

__device__ __forceinline__ void score4(const bf16* krow, const LAS f32x4* q4, float& s0, float& s1, float& s2, float& s3) {
    s0 = 0.f; s1 = 0.f; s2 = 0.f; s3 = 0.f;
#pragma unroll 2
    for (int dd = 0; dd < 16; ++dd) {
        const v4u kv = *(const v4u*)(krow + 8 * dd);
#pragma unroll
        for (int e = 0; e < 4; ++e) { const float k0 = bflo(kv[e]), k1 = bfhi(kv[e]); const f32x4 qa = q4[8 * dd + 2 * e], qb = q4[8 * dd + 2 * e + 1];
            s0 += qa.x * k0; s1 += qa.y * k0; s2 += qa.z * k0; s3 += qa.w * k0;
            s0 += qb.x * k1; s1 += qb.y * k1; s2 += qb.z * k1; s3 += qb.w * k1; }
    }
}
struct Acc8 { float a[4][2]; };
__device__ __forceinline__ void pv64(const bf16* V, size_t ld, int row0, int rmax, const LAS f32x4* pl, int lane, Acc8& A) {
#pragma unroll 4
    for (int j = 0; j < 64; ++j) {
        int r = row0 + j; r = r < 0 ? 0 : (r > rmax ? rmax : r);
        const unsigned vv = *(const unsigned*)(V + (size_t)r * ld + 2 * lane);
        const float v0 = bflo(vv), v1 = bfhi(vv); const f32x4 p = pl[j];
        A.a[0][0] += p.x * v0; A.a[0][1] += p.x * v1; A.a[1][0] += p.y * v0; A.a[1][1] += p.y * v1;
        A.a[2][0] += p.z * v0; A.a[2][1] += p.z * v1; A.a[3][0] += p.w * v0; A.a[3][1] += p.w * v1;
    }
}
template <int NC>
__device__ __forceinline__ void softmax4(float (&s)[NC][4], const float (&gate)[4], bool scale_by_gate) {
#pragma unroll
    for (int h = 0; h < 4; ++h) {
        float m = -__builtin_inff();
#pragma unroll
        for (int c = 0; c < NC; ++c) m = fmaxf(m, s[c][h]);
        m = wave_max(m);
        if (!(m > -__builtin_inff())) m = 0.f;
        float den = 0.f;
#pragma unroll
        for (int c = 0; c < NC; ++c) { s[c][h] = __expf(s[c][h] - m); den += s[c][h]; }
        den = wave_sum(den);
        const float inv = (den > 0.f ? 1.0f / den : 1.0f) * (scale_by_gate ? gate[h] : 1.0f);
#pragma unroll
        for (int c = 0; c < NC; ++c) s[c][h] *= inv;
    }
}

__device__ __forceinline__ void nsa_phase(Frame& F, int l) {
    const int lane = F.lane;
    const bf16* z = (const bf16*)(F.ws + WS_Z);
    const bf16* kcmp = (const bf16*)(F.ws + WS_KCMP); const bf16* vcmp = (const bf16*)(F.ws + WS_VCMP);
    bf16* attn = (bf16*)(F.ws + WS_ATTN);
    LAS unsigned char* wl = F.lds + F.wave * 8192;
    LAS f32x4* q4 = (LAS f32x4*)wl;
    LAS f32x4* pl = (LAS f32x4*)(wl + 2048);
    LAS float* psl = (LAS float*)(wl + 3072);
    const int gw = F.bid * 8 + F.wave, NGW = F.G * 8;
    const float NEG = -__builtin_inff();
    for (int it = gw; it < S * 2; it += NGW) {
        const int t = it >> 1, g = it & 1;
        const bf16* zr = z + (size_t)t * ZLD;
        for (int i = lane; i < 512; i += 64) { const int h = i >> 7, d = i & 127; ((LAS float*)q4)[d * 4 + h] = bf2f(zr[ZQ + (g * 4 + h) * 128 + d]) * QSCALE; }
        float gc[4], gs[4], gwn[4];
#pragma unroll
        for (int h = 0; h < 4; ++h) { gc[h] = sigmoidf_(bf2f(zr[ZAG + (g * 4 + h) * 3 + 0])); gs[h] = sigmoidf_(bf2f(zr[ZAG + (g * 4 + h) * 3 + 1])); gwn[h] = sigmoidf_(bf2f(zr[ZAG + (g * 4 + h) * 3 + 2])); }
        LDS_WAIT(); asm volatile("" ::: "memory");
        Acc8 O;
#pragma unroll
        for (int h = 0; h < 4; ++h) { O.a[h][0] = 0.f; O.a[h][1] = 0.f; }
        const int cur = t >> 6;
        int sel[16];
        {
            const int nvalid = t >= 31 ? ((t - 31) >> 4) + 1 : 0;
            const int nch = (nvalid + 63) >> 6;
            float s[8][4];
#pragma unroll
            for (int c = 0; c < 8; ++c) {
                if (c < nch) { const int n = 64 * c + lane; const bool ok = n < nvalid; const int nr = ok ? n : 0;
                    score4(kcmp + (size_t)(nr * 2 + g) * 128, q4, s[c][0], s[c][1], s[c][2], s[c][3]);
                    if (!ok) { s[c][0] = NEG; s[c][1] = NEG; s[c][2] = NEG; s[c][3] = NEG; } }
                else { s[c][0] = NEG; s[c][1] = NEG; s[c][2] = NEG; s[c][3] = NEG; }
            }
            softmax4<8>(s, gc, false);
            if (lane == 0) psl[0] = 0.f;
#pragma unroll
            for (int c = 0; c < 8; ++c) psl[1 + 64 * c + lane] = (s[c][0] + s[c][1]) + (s[c][2] + s[c][3]);
            if (lane < 7) psl[513 + lane] = 0.f;
            LDS_WAIT(); asm volatile("" ::: "memory");
            unsigned cv[2]; int cm[2];
#pragma unroll
            for (int k = 0; k < 2; ++k) { const int m = lane + 64 * k; cm[k] = m;
                const float imp = 0.5f * psl[4 * m] + psl[4 * m + 1] + psl[4 * m + 2] + psl[4 * m + 3] + 0.5f * psl[4 * m + 4];
                const bool forced = (m == 0) || (m == cur) || (m == cur - 1);
                cv[k] = (m > cur) ? 0u : (forced ? 0x7f800001u : __float_as_uint(imp) + 1u); }
            const int K = cur + 1 < TOPK ? cur + 1 : TOPK;
#pragma unroll
            for (int i = 0; i < 16; ++i) {
                if (i < K) {
                    unsigned bv; int bm;
                    if (cv[0] >= cv[1]) { bv = cv[0]; bm = cm[0]; } else { bv = cv[1]; bm = cm[1]; }
#pragma unroll
                    for (int o = 1; o < 64; o <<= 1) { const unsigned ov = __shfl_xor(bv, o); const int om = __shfl_xor(bm, o);
                        if (ov > bv || (ov == bv && om < bm)) { bv = ov; bm = om; } }
                    sel[i] = __builtin_amdgcn_readfirstlane(bm);
                    if (cm[0] == bm) cv[0] = 0u; if (cm[1] == bm) cv[1] = 0u;
                } else sel[i] = -1;
            }
#pragma unroll
            for (int c = 0; c < 8; ++c) {
                if (c < nch) {
                    pl[lane] = (f32x4){s[c][0] * gc[0], s[c][1] * gc[1], s[c][2] * gc[2], s[c][3] * gc[3]};
                    LDS_WAIT(); asm volatile("" ::: "memory");
                    pv64(vcmp + g * 128, 256, 64 * c, NCMP - 1, pl, lane, O);
                    LDS_WAIT(); asm volatile("" ::: "memory");
                }
            }
        }
        {
            float s[16][4];
#pragma unroll
            for (int c = 0; c < 16; ++c) {
                if (sel[c] >= 0) { const int key = sel[c] * 64 + lane; const bool ok = key <= t; const int kr = ok ? key : 0;
                    score4(z + (size_t)kr * ZLD + ZKS + g * 128, q4, s[c][0], s[c][1], s[c][2], s[c][3]);
                    if (!ok) { s[c][0] = NEG; s[c][1] = NEG; s[c][2] = NEG; s[c][3] = NEG; } }
                else { s[c][0] = NEG; s[c][1] = NEG; s[c][2] = NEG; s[c][3] = NEG; }
            }
            softmax4<16>(s, gs, true);
#pragma unroll
            for (int c = 0; c < 16; ++c) {
                if (sel[c] >= 0) {
                    pl[lane] = (f32x4){s[c][0], s[c][1], s[c][2], s[c][3]};
                    LDS_WAIT(); asm volatile("" ::: "memory");
                    pv64(z + ZVS + g * 128, ZLD, sel[c] * 64, S - 1, pl, lane, O);
                    LDS_WAIT(); asm volatile("" ::: "memory");
                }
            }
        }
        {
            float s[8][4];
            const int base = t - (WINDOW - 1);
#pragma unroll
            for (int c = 0; c < 8; ++c) {
                if (base + 64 * c + 63 >= 0) { const int key = base + 64 * c + lane; const bool ok = key >= 0; const int kr = ok ? key : 0;
                    score4(z + (size_t)kr * ZLD + ZKW + g * 128, q4, s[c][0], s[c][1], s[c][2], s[c][3]);
                    if (!ok) { s[c][0] = NEG; s[c][1] = NEG; s[c][2] = NEG; s[c][3] = NEG; } }
                else { s[c][0] = NEG; s[c][1] = NEG; s[c][2] = NEG; s[c][3] = NEG; }
            }
            softmax4<8>(s, gwn, true);
#pragma unroll
            for (int c = 0; c < 8; ++c) {
                if (base + 64 * c + 63 >= 0) {
                    pl[lane] = (f32x4){s[c][0], s[c][1], s[c][2], s[c][3]};
                    LDS_WAIT(); asm volatile("" ::: "memory");
                    pv64(z + ZVW + g * 128, ZLD, base + 64 * c, S - 1, pl, lane, O);
                    LDS_WAIT(); asm volatile("" ::: "memory");
                }
            }
        }
#pragma unroll
        for (int h = 0; h < 4; ++h) *(unsigned*)(attn + (size_t)t * 1024 + (g * 4 + h) * 128 + 2 * lane) = pk2(O.a[h][0], O.a[h][1]);
        LDS_WAIT(); asm volatile("" ::: "memory");
    }
}

__device__ __forceinline__ void hgrn_pass3(Frame& F, int l) {
    constexpr int LDP = 132;
    const int lane = F.lane, w = F.wave;
    LAS float* Qs = (LAS float*)F.lds;
    LAS float* Ks = Qs + 64 * LDP;
    LAS float* Bs = Ks + 64 * LDP;
    LAS float* Vs = Bs + 64 * LDP;
    const bf16* z = (const bf16*)(F.ws + WS_Z);
    const float* lbv = (const float*)(F.ws + WS_LB) + l * 1024;
    const float* hgS = (const float*)(F.ws + WS_HGS);
    const float* gn = inp(F, 12) + (size_t)l * 1024;
    bf16* hg = (bf16*)(F.ws + WS_HG);
    for (int it = F.bid; it < HGNC * 8; it += F.G) {
        const int c = it >> 3, h = it & 7;
        for (int i = F.tid; i < 64 * 128; i += 512) { const int t = i >> 7, d = i & 127; const bf16* zr = z + (size_t)(c * HGC + t) * ZLD + h * 128 + d;
            Bs[t * LDP + d] = log_f_of(bf2f(zr[ZFH]), lbv[h * 128 + d]); Qs[t * LDP + d] = bf2f(zr[ZQH]); Vs[t * 128 + d] = bf2f(zr[ZIH]); }
        __syncthreads();
        if (F.tid < 128) { float run = 0.f; const int d = F.tid;
            for (int t = 0; t < 64; ++t) { const float lf = Bs[t * LDP + d]; run += lf; Bs[t * LDP + d] = run; Ks[t * LDP + d] = -expm1f(lf); } }
        __syncthreads();
        float a[8];
#pragma unroll
        for (int i = 0; i < 8; ++i) a[i] = 0.f;
        for (int d = 0; d < 128; d += 4) {
            const f32x4 ks = *(const LAS f32x4*)(Ks + lane * LDP + d), bs = *(const LAS f32x4*)(Bs + lane * LDP + d);
#pragma unroll
            for (int i = 0; i < 8; ++i) { const f32x4 qt = *(const LAS f32x4*)(Qs + (8 * w + i) * LDP + d), bt = *(const LAS f32x4*)(Bs + (8 * w + i) * LDP + d);
#pragma unroll
                for (int e = 0; e < 4; ++e) a[i] += qt[e] * ks[e] * __expf(fminf(bt[e] - bs[e], 0.f)); }
        }
#pragma unroll
        for (int i = 0; i < 8; ++i) if (lane > 8 * w + i) a[i] = 0.f;
        for (int i = lane; i < 8 * 128; i += 64) { const int tt = 8 * w + (i >> 7), d = i & 127; Qs[tt * LDP + d] *= __expf(Bs[tt * LDP + d]); }
        __syncthreads();
#pragma unroll
        for (int i = 0; i < 8; ++i) Ks[(8 * w + i) * 64 + lane] = a[i];
        __syncthreads();
        float o[8][2];
#pragma unroll
        for (int i = 0; i < 8; ++i) { o[i][0] = 0.f; o[i][1] = 0.f; }
        for (int s = 0; s < 64; s += 4) {
            f32x4 a4[8];
#pragma unroll
            for (int i = 0; i < 8; ++i) a4[i] = *(const LAS f32x4*)(Ks + (8 * w + i) * 64 + s);
#pragma unroll
            for (int e = 0; e < 4; ++e) { const float v0 = Vs[(s + e) * 128 + lane], v1 = Vs[(s + e) * 128 + lane + 64];
#pragma unroll
                for (int i = 0; i < 8; ++i) { o[i][0] += a4[i][e] * v0; o[i][1] += a4[i][e] * v1; } }
        }
        const float* Sg = hgS + (size_t)it * 16384;
        for (int d = 0; d < 128; d += 4) {
            f32x4 q4v[8];
#pragma unroll
            for (int i = 0; i < 8; ++i) q4v[i] = *(const LAS f32x4*)(Qs + (8 * w + i) * LDP + d);
#pragma unroll
            for (int e = 0; e < 4; ++e) { const float s0 = Sg[(d + e) * 128 + lane], s1 = Sg[(d + e) * 128 + lane + 64];
#pragma unroll
                for (int i = 0; i < 8; ++i) { o[i][0] += q4v[i][e] * s0; o[i][1] += q4v[i][e] * s1; } }
        }
        const float g0 = gn[h * 128 + lane], g1 = gn[h * 128 + lane + 64];
#pragma unroll
        for (int i = 0; i < 8; ++i) {
            const int tok = c * HGC + 8 * w + i;
            const float ss = wave_sum(o[i][0] * o[i][0] + o[i][1] * o[i][1]);
            const float r = 1.0f / sqrtf(ss * (1.0f / 128.0f) + EPS);
            const bf16* zr = z + (size_t)tok * ZLD + ZOG + h * 128;
            const float og0 = bf2f(zr[lane]), og1 = bf2f(zr[lane + 64]);
            hg[(size_t)tok * 1024 + h * 128 + lane] = (bf16)f2bf(o[i][0] * r * g0 * siluf_(og0));
            hg[(size_t)tok * 1024 + h * 128 + lane + 64] = (bf16)f2bf(o[i][1] * r * g1 * siluf_(og1));
        }
        __syncthreads();
    }
}

using pg8::Unit; using pg8::f32x4;
struct EpiGateF32 {
    static constexpr bool PERM = false, AFTER_DRAIN = false;
    float* C; int ldc; const bf16* G; int ldg;
    __device__ __forceinline__ void operator()(const pg8::f32x4 (&acc)[2][2][4][2], const Unit& u, int wr, int wc, int fr, int fq) const {
        const int row0 = u.pm * 256 + wr * 64 + fr, col0 = u.pn * 256 + wc * 32 + 4 * fq;
#pragma unroll
        for (int ai = 0; ai < 2; ++ai)
#pragma unroll
            for (int m = 0; m < 4; ++m) { const size_t row = (size_t)(row0 + ai * 128 + m * 16);
#pragma unroll
                for (int bj = 0; bj < 2; ++bj)
#pragma unroll
                    for (int n = 0; n < 2; ++n) { const int col = col0 + bj * 128 + n * 16;
                        const v2u gw = *(const v2u*)(G + row * ldg + col);
                        pg8::f32x4 gv = {sigmoidf_(bflo(gw.x)), sigmoidf_(bfhi(gw.x)), sigmoidf_(bflo(gw.y)), sigmoidf_(bfhi(gw.y))};
                        *(pg8::f32x4*)(C + row * ldc + col) = acc[ai][bj][m][n] * gv; } }
    }
};
struct EpiMixBf16 {
    static constexpr bool PERM = true, AFTER_DRAIN = false;
    bf16* O; int ldc; const float* P; const bf16* G; int ldg;
    __device__ __forceinline__ void operator()(const pg8::f32x4 (&acc)[2][2][4][2], const Unit& u, int wr, int wc, int fr, int fq) const {
        const int row0 = u.pm * 256 + wr * 64 + fr, col0 = u.pn * 256 + wc * 32 + 8 * fq;
#pragma unroll
        for (int ai = 0; ai < 2; ++ai)
#pragma unroll
            for (int m = 0; m < 4; ++m) { const size_t row = (size_t)(row0 + ai * 128 + m * 16);
#pragma unroll
                for (int bj = 0; bj < 2; ++bj) { const int col = col0 + bj * 128;
                    const v4u gw = *(const v4u*)(G + row * ldg + col);
                    const pg8::f32x4 p0 = *(const pg8::f32x4*)(P + row * ldc + col), p1 = *(const pg8::f32x4*)(P + row * ldc + col + 4);
                    const pg8::f32x4 g0 = {sigmoidf_(bflo(gw.x)), sigmoidf_(bfhi(gw.x)), sigmoidf_(bflo(gw.y)), sigmoidf_(bfhi(gw.y))};
                    const pg8::f32x4 g1 = {sigmoidf_(bflo(gw.z)), sigmoidf_(bfhi(gw.z)), sigmoidf_(bflo(gw.w)), sigmoidf_(bfhi(gw.w))};
                    const pg8::f32x4 v0 = p0 + acc[ai][bj][m][0] * g0, v1 = p1 + acc[ai][bj][m][1] * g1;
                    v4u w; w.x = pk2(v0[0], v0[1]); w.y = pk2(v0[2], v0[3]); w.z = pk2(v1[0], v1[1]); w.w = pk2(v1[2], v1[3]);
                    *(v4u*)(O + row * ldc + col) = w; } }
    }
};

__device__ __forceinline__ void conv_phase(Frame& F, int l) {
    const int gtid = F.bid * 512 + F.tid, NT = F.G * 512;
    const bf16* u = (const bf16*)(F.ws + WS_Z); bf16* gb = (bf16*)(F.ws + WS_G);
    const float* cw = inp(F, 19) + (size_t)l * 3 * NUP; const float* cb = inp(F, 20) + (size_t)l * NUP;
    for (int idx = gtid; idx < S * (DFF / 8); idx += NT) {
        const int t = idx / (DFF / 8), c = 8 * (idx % (DFF / 8));
        float og[8], ov[8];
#pragma unroll
        for (int e = 0; e < 8; ++e) { og[e] = cb[c + e]; ov[e] = cb[DFF + c + e]; }
#pragma unroll
        for (int j = 0; j < 3; ++j) {
            const int tt = t - 2 + j;
            if (tt >= 0) {
                const v4u a = *(const v4u*)(u + (size_t)tt * NUP + c), b = *(const v4u*)(u + (size_t)tt * NUP + DFF + c);
#pragma unroll
                for (int e = 0; e < 4; ++e) {
                    og[2 * e] += cw[j * NUP + c + 2 * e] * bflo(a[e]); og[2 * e + 1] += cw[j * NUP + c + 2 * e + 1] * bfhi(a[e]);
                    ov[2 * e] += cw[j * NUP + DFF + c + 2 * e] * bflo(b[e]); ov[2 * e + 1] += cw[j * NUP + DFF + c + 2 * e + 1] * bfhi(b[e]); }
            }
        }
        v4u w;
#pragma unroll
        for (int e = 0; e < 4; ++e) w[e] = pk2(siluf_(og[2 * e]) * ov[2 * e], siluf_(og[2 * e + 1]) * ov[2 * e + 1]);
        *(v4u*)(gb + (size_t)t * DFF + c) = w;
    }
}

__device__ __forceinline__ void make_frame(Frame& F, const Args& args, unsigned char* lds_raw) {
    F.lds = (LAS unsigned char*)lds_raw;
    F.tid = threadIdx.x; F.lane = F.tid & 63; F.wave = __builtin_amdgcn_readfirstlane(F.tid >> 6);
    F.G = gridDim.x; F.bid = blockIdx.x; F.ws = args.ws; F.out = args.out;
    for (int u = F.tid; u < (LDS_BYTES - LDSCTL_OFF) / 4; u += 512) ((LAS unsigned*)(F.lds + LDSCTL_OFF))[u] = 0u;
    __syncthreads();
    if (F.tid == 0) {
#pragma unroll
        for (int i = 0; i < 23; ++i) ((LAS unsigned long long*)(F.lds + LDSCTL_OFF + 128))[i] = (unsigned long long)args.in[i];
    }
    __syncthreads();
}
__device__ __forceinline__ void relaunder(Frame& F, const Args& args) {
    int t = threadIdx.x; asm volatile("" : "+v"(t)); F.tid = t; F.lane = t & 63; F.wave = __builtin_amdgcn_readfirstlane(t >> 6);
    int b = blockIdx.x; asm volatile("" : "+s"(b)); F.bid = b;
    unsigned char* w = args.ws; asm volatile("" : "+s"(w)); F.ws = w;
    float* o = args.out; asm volatile("" : "+s"(o)); F.out = o;
}
constexpr int PH_PER_LAYER = 12, PH_FIRST = 3, N_PHASES = PH_FIRST + NL * PH_PER_LAYER;

__global__ void __launch_bounds__(512, 2) fwd(Args args) {
    extern __shared__ __attribute__((aligned(16))) unsigned char lds_raw[];
    Frame F; make_frame(F, args, lds_raw);
    const int lo = args.ph_lo, hi = args.ph_hi;
    unsigned* barw = (unsigned*)(F.ws + WS_CTL) + CW_BAR;
    XcdBarrier bar; bar.bar = barw; bar.x = 0; bar.st = nullptr;
    if (hi - lo > 1) bar = xcd_barrier_post(barw, (volatile LAS unsigned*)(F.lds + LDSCTL_OFF));
#define IN(k) (lo <= (k) && (k) < hi)
#define PH(k) if (IN(k) && (relaunder(F, args), true))
#define SEAM(k) do { if (IN(k) && IN((k) + 1)) xcd_barrier(bar); } while (0)

#define ada ((const float*)(F.ws + WS_ADA))
#define hbuf ((bf16*)(F.ws + WS_H))
#define zbuf ((bf16*)(F.ws + WS_Z))
#define ybuf ((float*)(F.ws + WS_Y))
#define part ((float*)(F.ws + WS_PART))
#define mixed ((bf16*)(F.ws + WS_MIXED))
#define gbuf ((bf16*)(F.ws + WS_G))
#define attn ((bf16*)(F.ws + WS_ATTN))
#define hgb ((bf16*)(F.ws + WS_HG))

    PH(0) { p0_prologue(F); } SEAM(0);
    PH(1) { p0b_ada(F); } SEAM(1);
    PH(2) { row_phase<false, true>(F, inp(F, 0), nullptr, nullptr, hbuf, nullptr, nullptr, inp(F, 5), ada + 1 * D, ada + 0 * D); } SEAM(2);

    for (int l = 0; l < NL; ++l) {
        const int pb = PH_FIRST + l * PH_PER_LAYER;
#define adal (ada + (size_t)l * NADA)
        PH(pb + 0) {
            pg8::Gemm g{hbuf, (const bf16*)(F.ws + WS_WIN) + (size_t)l * ZLD * D, S, ZLD, D}; pg8::StaticOrder So; So.init(S, ZLD, F.G, F.bid);
            pg8::EpiBf16<0> E{zbuf, ZLD, nullptr, 0, 0};
            pg8::gemm_phase<pg8::EpiBf16<0>, pg8::StaticOrder, false>(F.lds, g, So, E, nullptr);
        } SEAM(pb + 0);
        PH(pb + 1) { phase_c(F, l); } SEAM(pb + 1);
        PH(pb + 2) { hgrn_pass2(F); __syncthreads(); nsa_phase(F, l); } SEAM(pb + 2);
        PH(pb + 3) { hgrn_pass3(F, l); } SEAM(pb + 3);
        PH(pb + 4) {
            pg8::Gemm g{attn, (const bf16*)(F.ws + WS_WBA) + (size_t)l * D * 1024, S, D, 1024}; pg8::StaticOrder So; So.init(S, D, F.G, F.bid);
            EpiGateF32 E{part, D, zbuf + ZMG, ZLD};
            pg8::gemm_phase<EpiGateF32, pg8::StaticOrder, false>(F.lds, g, So, E, nullptr);
        } SEAM(pb + 4);
        PH(pb + 5) {
            pg8::Gemm g{hgb, (const bf16*)(F.ws + WS_WBH) + (size_t)l * D * 1024, S, D, 1024}; pg8::StaticOrder So; So.init(S, D, F.G, F.bid);
            EpiMixBf16 E{mixed, D, part, zbuf + ZMG + D, ZLD};
            pg8::gemm_phase<EpiMixBf16, pg8::StaticOrder, false>(F.lds, g, So, E, nullptr);
        } SEAM(pb + 5);
        PH(pb + 6) {
            pg8::Gemm g{mixed, (const bf16*)(F.ws + WS_WOUT) + (size_t)l * D * D, S, D, D}; pg8::StaticOrder So; So.init(S, D, F.G, F.bid);
            pg8::EpiF32 E{ybuf, D, nullptr};
            pg8::gemm_phase<pg8::EpiF32, pg8::StaticOrder, false>(F.lds, g, So, E, nullptr);
        } SEAM(pb + 6);
        PH(pb + 7) { row_phase<true, true>(F, l == 0 ? inp(F, 0) : F.out, ybuf, F.out, hbuf, inp(F, 16) + (size_t)l * D, adal + 2 * D, inp(F, 17) + (size_t)l * D, adal + 4 * D, adal + 3 * D); } SEAM(pb + 7);
        PH(pb + 8) {
            pg8::Gemm g{hbuf, (const bf16*)(F.ws + WS_WUP) + (size_t)l * NUP * D, S, NUP, D}; pg8::StaticOrder So; So.init(S, NUP, F.G, F.bid);
            pg8::EpiBf16<0> E{zbuf, NUP, nullptr, 0, 0};
            pg8::gemm_phase<pg8::EpiBf16<0>, pg8::StaticOrder, false>(F.lds, g, So, E, nullptr);
        } SEAM(pb + 8);
        PH(pb + 9) { conv_phase(F, l); } SEAM(pb + 9);
        PH(pb + 10) {
            pg8::Gemm g{gbuf, (const bf16*)(F.ws + WS_WDN) + (size_t)l * D * DFF, S, D, DFF}; pg8::StaticOrder So; So.init(S, D, F.G, F.bid);
            pg8::EpiF32 E{ybuf, D, nullptr};
            pg8::gemm_phase<pg8::EpiF32, pg8::StaticOrder, false>(F.lds, g, So, E, nullptr);
        } SEAM(pb + 10);
        PH(pb + 11) {
            if (l + 1 < NL) row_phase<true, true>(F, F.out, ybuf, F.out, hbuf, inp(F, 22) + (size_t)l * D, adal + 5 * D, inp(F, 5) + (size_t)(l + 1) * D, adal + NADA + 1 * D, adal + NADA + 0 * D);
            else row_phase<true, false>(F, F.out, ybuf, F.out, hbuf, inp(F, 22) + (size_t)l * D, adal + 5 * D, nullptr, nullptr, nullptr);
        }
        if (l + 1 < NL) SEAM(pb + 11);
    }
#undef IN
#undef PH
#undef ada
#undef hbuf
#undef zbuf
#undef ybuf
#undef part
#undef mixed
#undef gbuf
#undef attn
#undef hgb
#undef adal
#undef SEAM
}
}

#ifndef MK_SINGLE
#define MK_SINGLE 0
#endif
extern "C" void kernel_launch(void* const* d_in, const int* in_sizes, int n_in, void* d_out, int out_size, void* d_ws, size_t ws_size, hipStream_t stream) {
    using namespace mk;
    static int grid = 0;
    if (grid == 0) {
        if (n_in != 23 || out_size != S * D || ws_size < WS_END) { fprintf(stderr, "kernel_launch: unexpected shapes (n_in %d out %d ws %zu)\n", n_in, out_size, ws_size); grid = -1; return; }
        int dev = 0, cus = 0, per_cu = 0;
        if (hipGetDevice(&dev) != hipSuccess || hipDeviceGetAttribute(&cus, hipDeviceAttributeMultiprocessorCount, dev) != hipSuccess) { grid = -1; return; }
        if (hipFuncSetAttribute((const void*)fwd, hipFuncAttributeMaxDynamicSharedMemorySize, LDS_BYTES) != hipSuccess) { fprintf(stderr, "kernel_launch: hipFuncSetAttribute failed\n"); grid = -1; return; }
        if (hipOccupancyMaxActiveBlocksPerMultiprocessor(&per_cu, (const void*)fwd, 512, LDS_BYTES) != hipSuccess || per_cu < 1) fprintf(stderr, "kernel_launch: occupancy query says %d\n", per_cu);
        (void)hipGetLastError();
        grid = cus;
    }
    if (grid < 0) return;
    (void)hipMemsetAsync((char*)d_ws + WS_CTL, 0, CTL_ZERO_BYTES, stream);
    Args a{};
    for (int i = 0; i < 23; ++i) a.in[i] = (const float*)d_in[i];
    a.out = (float*)d_out; a.ws = (unsigned char*)d_ws;
#if MK_SINGLE
    a.ph_lo = 0; a.ph_hi = N_PHASES;
    hipLaunchKernelGGL(fwd, dim3(grid), dim3(512), LDS_BYTES, stream, a);
#else
    for (int p = 0; p < N_PHASES; ++p) { a.ph_lo = p; a.ph_hi = p + 1; hipLaunchKernelGGL(fwd, dim3(grid), dim3(512), LDS_BYTES, stream, a); }
#endif
}
```

```cpp
#include <hip/hip_runtime.h>
#include <cstdio>
#include <cstdint>
#define MK_SINGLE 1
namespace pg8 {
#define PG8_LAS __attribute__((address_space(3)))
typedef unsigned short bf16_t;
typedef short bf16x8 __attribute__((ext_vector_type(8)));
typedef float f32x4 __attribute__((ext_vector_type(4)));
typedef unsigned u32x4 __attribute__((ext_vector_type(4)));
constexpr int BM = 256, BK = 64, HALF = 128, HTB = HALF * BK * 2  , STAGE_BYTES = 8 * HTB, NXCD = 8, WGM = 8;

__host__ __device__ __forceinline__ int lds_byte(int r, int c) { const int st = (r >> 4) * 2 + (c >> 5), rr = r & 15, cc = c & 31, ob = rr * 64 + cc * 2; return st * 1024 + (ob ^ (((ob >> 9) & 1) << 5)); }
__host__ __device__ __forceinline__ void stage_rc(int b, int& R, int& C) { const int st = b / 1024, sb = b % 1024, swz = sb ^ (((sb >> 9) & 1) << 5); R = (st >> 1) * 16 + swz / 64; C = (st & 1) * 32 + (swz % 64) / 2; }
__host__ __device__ __forceinline__ int perm32(int rho) { const int n = rho >> 4, i = rho & 15; return 8 * (i >> 2) + 4 * n + (i & 3); }

struct Unit { int pm, pn; };
struct Gemm { const bf16_t* A; const bf16_t* Bt; int M, N, K; };

struct StaticOrder {
    int nM, nN, nwg, G, c;
    __host__ __device__ void init(int M, int N, int G_, int c_) { nM = M / BM; nN = N / BM; nwg = nM * nN; G = G_; c = c_; }
    __host__ __device__ bool next(int i, Unit& u) const {
        const long L = (long)i * G + c; if (L >= nwg) return false;
        int wgid = (int)L; { const int q = nwg / NXCD, r = nwg % NXCD, xcd = wgid % NXCD, off = wgid / NXCD; wgid = (xcd < r ? xcd * (q + 1) : r * (q + 1) + (xcd - r) * q) + off; }
        const int nig = WGM * nN, gid = wgid / nig, fm = gid * WGM, gsz = (nM - fm) < WGM ? (nM - fm) : WGM;
        u.pm = fm + ((wgid % nig) % gsz); u.pn = (wgid % nig) / gsz; return true;
    }
    __device__ __forceinline__ void a_ready(const Unit&) const {}
    __device__ __forceinline__ void done(const Unit&) const {}
};
struct CountedOrder : StaticOrder {
    const unsigned* ready; unsigned need; unsigned* tmo;
    __device__ __forceinline__ void a_ready(const Unit& u) const {
        if (threadIdx.x < 64) {
            const unsigned long long t0 = __builtin_amdgcn_s_memrealtime(); unsigned polls = 0;
            while ((unsigned)__builtin_amdgcn_readfirstlane(__hip_atomic_load(ready + 64 * u.pm, __ATOMIC_RELAXED, __HIP_MEMORY_SCOPE_AGENT)) < need) {
                if ((++polls & 255u) == 0u && __builtin_amdgcn_readfirstlane(__hip_atomic_load(tmo, __ATOMIC_RELAXED, __HIP_MEMORY_SCOPE_AGENT)) != 0u) break;
                if (__builtin_amdgcn_s_memrealtime() - t0 > 2000000ull) {
                    if (threadIdx.x == 0) { unsigned expect = 0u; __hip_atomic_compare_exchange_strong(tmo + 1, &expect, 0x600u | (unsigned)(u.pm & 0xff), __ATOMIC_RELAXED, __ATOMIC_RELAXED, __HIP_MEMORY_SCOPE_AGENT); __hip_atomic_store(tmo, 1u, __ATOMIC_RELAXED, __HIP_MEMORY_SCOPE_AGENT); }
                    break; }
                __builtin_amdgcn_s_sleep(2); }
            __builtin_amdgcn_fence(__ATOMIC_ACQUIRE, "agent");
            asm volatile("s_waitcnt vmcnt(0)" ::: "memory");
        }
#if !defined(BROKEN_HOOK_NO_BARRIER)
        asm volatile("" ::: "memory"); __builtin_amdgcn_s_barrier(); asm volatile("" ::: "memory");
#endif
    }
};

typedef __bf16 bf16x2n_t __attribute__((ext_vector_type(2))); typedef float f32x2n_t __attribute__((ext_vector_type(2)));
__device__ __forceinline__ unsigned cvt_pk_bf16(float lo, float hi) { const f32x2n_t v = {lo, hi}; return __builtin_bit_cast(unsigned, __builtin_convertvector(v, bf16x2n_t)); }
typedef float f32x2 __attribute__((ext_vector_type(2)));
__device__ __forceinline__ f32x2 gelu_pk(f32x2 v) {
    const f32x2 av = __builtin_elementwise_abs(v), d = av * 0.2316418882f + 1.0f;
    f32x2 t; t.x = __builtin_amdgcn_rcpf(d.x); t.y = __builtin_amdgcn_rcpf(d.y);
    f32x2 q = t * 0.5307027145f + (-0.7265760135f); q = q * t + 0.7107068705f; q = q * t + (-0.142248368f); q = q * t + 0.127414796f; q = q * t;
    const f32x2 s = (v * v) * (-0.72134752044f);
    f32x2 e; e.x = __builtin_amdgcn_exp2f(s.x); e.y = __builtin_amdgcn_exp2f(s.y);
    const f32x2 m = v * (q * e), r = v - m;
    f32x2 o; o.x = v.x < 0.f ? m.x : r.x; o.y = v.y < 0.f ? m.y : r.y; return o;
}

struct EpiF32 {
    static constexpr bool PERM = false, AFTER_DRAIN = false;
    float* C; int ldc; const float* bias;
    __device__ __forceinline__ void operator()(const f32x4 (&acc)[2][2][4][2], const Unit& u, int wr, int wc, int fr, int fq) const {
        const int row0 = u.pm * BM + wr * 64 + fr, col0 = u.pn * BM + wc * 32 + 4 * fq;
        f32x4 bv[2][2];
#pragma unroll
        for (int bj = 0; bj < 2; ++bj)
#pragma unroll
            for (int n = 0; n < 2; ++n) bv[bj][n] = bias ? *(const f32x4*)(bias + col0 + bj * HALF + n * 16) : (f32x4){0.f, 0.f, 0.f, 0.f};
#pragma unroll
        for (int ai = 0; ai < 2; ++ai)
#pragma unroll
            for (int m = 0; m < 4; ++m) { float* rowp = C + (size_t)(row0 + ai * HALF + m * 16) * ldc + col0;
#pragma unroll
                for (int bj = 0; bj < 2; ++bj)
#pragma unroll
                    for (int n = 0; n < 2; ++n) *(f32x4*)(rowp + bj * HALF + n * 16) = acc[ai][bj][m][n] + bv[bj][n]; }
    }
};
template <int ACT  > struct EpiBf16 {
    static constexpr bool PERM = true, AFTER_DRAIN = false;
    bf16_t* O; int ldc; const float* bias; int split_cols; size_t split_stride;
    __device__ __forceinline__ void operator()(const f32x4 (&acc)[2][2][4][2], const Unit& u, int wr, int wc, int fr, int fq) const {
        const int row0 = u.pm * BM + wr * 64 + fr; int colt = u.pn * BM; bf16_t* base = O;
        if (split_cols) { const int t = colt / split_cols; base += (size_t)t * split_stride; colt -= t * split_cols; }
        const int col0 = colt + wc * 32 + 8 * fq, bcol0 = u.pn * BM + wc * 32 + 8 * fq;
        f32x4 bv[2][2];
#pragma unroll
        for (int bj = 0; bj < 2; ++bj)
#pragma unroll
            for (int n = 0; n < 2; ++n) bv[bj][n] = bias ? *(const f32x4*)(bias + bcol0 + bj * HALF + 4 * n) : (f32x4){0.f, 0.f, 0.f, 0.f};
#pragma unroll
        for (int ai = 0; ai < 2; ++ai)
#pragma unroll
            for (int m = 0; m < 4; ++m) { bf16_t* rowp = base + (size_t)(row0 + ai * HALF + m * 16) * ldc + col0;
#pragma unroll
                for (int bj = 0; bj < 2; ++bj) { f32x4 v0 = acc[ai][bj][m][0] + bv[bj][0], v1 = acc[ai][bj][m][1] + bv[bj][1];
                    if (ACT == 1) { f32x2 a = gelu_pk((f32x2){v0[0], v0[1]}), b = gelu_pk((f32x2){v0[2], v0[3]}), c = gelu_pk((f32x2){v1[0], v1[1]}), d = gelu_pk((f32x2){v1[2], v1[3]});
                        v0 = (f32x4){a.x, a.y, b.x, b.y}; v1 = (f32x4){c.x, c.y, d.x, d.y}; }
                    if (ACT == 2) {
#pragma unroll
                        for (int j = 0; j < 4; ++j) { v0[j] = 0.5f * v0[j] * (1.0f + erff(v0[j] * 0.70710678f)); v1[j] = 0.5f * v1[j] * (1.0f + erff(v1[j] * 0.70710678f)); } }
                    u32x4 w; w.x = cvt_pk_bf16(v0[0], v0[1]); w.y = cvt_pk_bf16(v0[2], v0[3]); w.z = cvt_pk_bf16(v1[0], v1[1]); w.w = cvt_pk_bf16(v1[2], v1[3]);
                    *(u32x4*)(rowp + bj * HALF) = w; } }
    }
};

struct PanelStats {
    unsigned* xbuf;
    unsigned* cnt;
    unsigned* tmo;
    int ntn; float eps;
    unsigned code;
    __device__ __forceinline__ bool run(const f32x4 (&v)[2][2][4][2], const Unit& u, int wr, int wc, int fr, int fq, PG8_LAS unsigned char* lds, int wid, int lane) const {
        typedef float f32x2v __attribute__((ext_vector_type(2)));
        PG8_LAS f32x2v* P = (PG8_LAS f32x2v*)lds;
        PG8_LAS f32x2v* S = (PG8_LAS f32x2v*)(lds + 8192);
        PG8_LAS unsigned* flag = (PG8_LAS unsigned*)(lds + 8192 + 2048);
#pragma unroll
        for (int ai = 0; ai < 2; ++ai)
#pragma unroll
            for (int m = 0; m < 4; ++m) {
                float s = 0.f;
#pragma unroll
                for (int bj = 0; bj < 2; ++bj)
#pragma unroll
                    for (int n = 0; n < 2; ++n) { const f32x4 x = v[ai][bj][m][n]; s += (x[0] + x[1]) + (x[2] + x[3]); }
                s += __shfl_xor(s, 16); s += __shfl_xor(s, 32);
                const float mw = s * (1.0f / 64.0f); float q = 0.f;
#pragma unroll
                for (int bj = 0; bj < 2; ++bj)
#pragma unroll
                    for (int n = 0; n < 2; ++n) { const f32x4 d = v[ai][bj][m][n] - mw; q += (d[0] * d[0] + d[1] * d[1]) + (d[2] * d[2] + d[3] * d[3]); }
                q += __shfl_xor(q, 16); q += __shfl_xor(q, 32);
                if (fq == 0) P[(ai * HALF + wr * 64 + m * 16 + fr) * 4 + wc] = (f32x2v){mw, q};
            }
        asm volatile("s_waitcnt lgkmcnt(0)" ::: "memory"); __builtin_amdgcn_s_barrier(); asm volatile("" ::: "memory");
#if defined(BROKEN_NO_WAIT)
        if (blockIdx.x >= 64) { const long long t0 = clock64(); while (clock64() - t0 < 60000) __builtin_amdgcn_s_sleep(8); }
#endif
        const int row = wid * 32 + (lane & 31);
        if (lane < 32) {
            const f32x2v a = P[row * 4 + 0], b = P[row * 4 + 1], c = P[row * 4 + 2], d = P[row * 4 + 3];
            const float mt = (a.x + b.x + c.x + d.x) * 0.25f;
            const float da = a.x - mt, db = b.x - mt, dc = c.x - mt, dd = d.x - mt;
            const float m2 = (a.y + b.y) + (c.y + d.y) + 64.0f * ((da * da + db * db) + (dc * dc + dd * dd));
            unsigned long long* slot = (unsigned long long*)xbuf + ((size_t)(u.pm * BM + row) * 4 + u.pn);
            __hip_atomic_store(slot, ((unsigned long long)__float_as_uint(m2) << 32) | __float_as_uint(mt), __ATOMIC_RELAXED, __HIP_MEMORY_SCOPE_AGENT);
        }
        asm volatile("s_waitcnt vmcnt(0)" ::: "memory");
        if (lane == 0) __hip_atomic_fetch_add(cnt + 64 * u.pm, 1u, __ATOMIC_RELAXED, __HIP_MEMORY_SCOPE_AGENT);
        if (wid == 0) {
            bool dead = false; const unsigned long long t0 = __builtin_amdgcn_s_memrealtime(); const unsigned want = 8u * (unsigned)ntn;
            for (;;) {
#if defined(BROKEN_NO_WAIT)
                break;
#endif
                if ((unsigned)__builtin_amdgcn_readfirstlane(__hip_atomic_load(cnt + 64 * u.pm, __ATOMIC_RELAXED, __HIP_MEMORY_SCOPE_AGENT)) >= want) break;
                if (__builtin_amdgcn_s_memrealtime() - t0 > 2000000ull) {
                    if (lane == 0) { unsigned expect = 0u; __hip_atomic_compare_exchange_strong(tmo + 1, &expect, code | (unsigned)(u.pm & 0xff), __ATOMIC_RELAXED, __ATOMIC_RELAXED, __HIP_MEMORY_SCOPE_AGENT);
                                     __hip_atomic_store(tmo, 1u, __ATOMIC_RELAXED, __HIP_MEMORY_SCOPE_AGENT); }
                    dead = true; break; }
                __builtin_amdgcn_s_sleep(2);
            }
            __builtin_amdgcn_fence(__ATOMIC_ACQUIRE, "agent");
            if (lane == 0) flag[0] = dead ? 1u : 0u;
        }
        asm volatile("s_waitcnt vmcnt(0) lgkmcnt(0)" ::: "memory"); __builtin_amdgcn_s_barrier(); asm volatile("" ::: "memory");
        const bool bad = flag[0] != 0u;
        if (lane < 32) {
            const unsigned long long* slot = (const unsigned long long*)xbuf + (size_t)(u.pm * BM + row) * 4; float mt[4], m2[4]; float ms = 0.f;
#pragma unroll
            for (int t = 0; t < 4; ++t) { if (t < ntn) { const unsigned long long w = __hip_atomic_load(slot + t, __ATOMIC_RELAXED, __HIP_MEMORY_SCOPE_AGENT); mt[t] = __uint_as_float((unsigned)w); m2[t] = __uint_as_float((unsigned)(w >> 32)); } else { mt[t] = 0.f; m2[t] = 0.f; } ms += mt[t]; }
            const float mean = ms / (float)ntn; float q = 0.f;
#pragma unroll
            for (int t = 0; t < 4; ++t) if (t < ntn) { const float dm = mt[t] - mean; q += m2[t] + 256.0f * dm * dm; }
            S[row] = (f32x2v){mean, 1.0f / sqrtf(q / (256.0f * (float)ntn) + eps)};
        }
        asm volatile("s_waitcnt lgkmcnt(0)" ::: "memory"); __builtin_amdgcn_s_barrier(); asm volatile("" ::: "memory");
        return bad;
    }
};
struct EpiLnRes {
    static constexpr bool PERM = false, AFTER_DRAIN = true;
    const float* base; float* out; int ldc; const float* bias; PanelStats st; unsigned poison;
    __device__ __forceinline__ void refuse(size_t i0, size_t stride, int M, int N) const { const float q = __builtin_nanf(""); for (size_t i = i0; i < (size_t)M * N; i += stride) out[(i / N) * ldc + i % N] = q;
        if (i0 == 0) { unsigned expect = 0u; __hip_atomic_compare_exchange_strong(st.tmo + 1, &expect, 0x7f0u, __ATOMIC_RELAXED, __ATOMIC_RELAXED, __HIP_MEMORY_SCOPE_AGENT); __hip_atomic_store(st.tmo, 1u, __ATOMIC_RELAXED, __HIP_MEMORY_SCOPE_AGENT); } }
    __device__ __forceinline__ void fused(f32x4 (&acc)[2][2][4][2], const Unit& u, int wr, int wc, int fr, int fq, PG8_LAS unsigned char* lds, int wid, int lane) const {
        typedef float f32x2v __attribute__((ext_vector_type(2)));
        const PG8_LAS f32x2v* S = (const PG8_LAS f32x2v*)(lds + 8192);
        const int col0 = u.pn * BM + wc * 32 + 4 * fq;
#pragma unroll
        for (int bj = 0; bj < 2; ++bj)
#pragma unroll
            for (int n = 0; n < 2; ++n) { const f32x4 bv = bias ? *(const f32x4*)(bias + col0 + bj * HALF + n * 16) : (f32x4){0.f, 0.f, 0.f, 0.f};
#pragma unroll
                for (int ai = 0; ai < 2; ++ai)
#pragma unroll
                    for (int m = 0; m < 4; ++m) acc[ai][bj][m][n] += bv; }
        const bool bad = st.run(acc, u, wr, wc, fr, fq, lds, wid, lane) || poison != 0u;
        const float qnan = __builtin_nanf("");
#pragma unroll
        for (int ai = 0; ai < 2; ++ai)
#pragma unroll
            for (int m = 0; m < 4; ++m) { const int r = ai * HALF + wr * 64 + m * 16 + fr; const f32x2v sr = S[r]; const size_t off = (size_t)(u.pm * BM + r) * ldc + col0;
#pragma unroll
                for (int bj = 0; bj < 2; ++bj)
#pragma unroll
                    for (int n = 0; n < 2; ++n) { const f32x4 bs = *(const f32x4*)(base + off + bj * HALF + n * 16); f32x4 o = bs + (acc[ai][bj][m][n] - sr.x) * sr.y;
                        if (bad) o = (f32x4){qnan, qnan, qnan, qnan}; *(f32x4*)(out + off + bj * HALF + n * 16) = o; }
                asm volatile("" ::: "memory"); }
    }
};
struct EpiLnResLn {
    static constexpr bool PERM = false, AFTER_DRAIN = true;
    const float* base; float* out; bf16_t* xn; int ldc; const float* bias; PanelStats st1, st2; unsigned poison;
    __device__ __forceinline__ void refuse(size_t i0, size_t stride, int M, int N) const { const float q = __builtin_nanf(""); for (size_t i = i0; i < (size_t)M * N; i += stride) { const size_t o = (i / N) * ldc + i % N; out[o] = q; xn[o] = (bf16_t)0x7fc0u; }
        if (i0 == 0) { unsigned expect = 0u; __hip_atomic_compare_exchange_strong(st1.tmo + 1, &expect, 0x7f0u, __ATOMIC_RELAXED, __ATOMIC_RELAXED, __HIP_MEMORY_SCOPE_AGENT); __hip_atomic_store(st1.tmo, 1u, __ATOMIC_RELAXED, __HIP_MEMORY_SCOPE_AGENT); } }
    __device__ __forceinline__ void fused(f32x4 (&acc)[2][2][4][2], const Unit& u, int wr, int wc, int fr, int fq, PG8_LAS unsigned char* lds, int wid, int lane) const {
        typedef float f32x2v __attribute__((ext_vector_type(2))); typedef unsigned u32x2v __attribute__((ext_vector_type(2)));
        const PG8_LAS f32x2v* S = (const PG8_LAS f32x2v*)(lds + 8192);
        const int col0 = u.pn * BM + wc * 32 + 4 * fq;
#pragma unroll
        for (int bj = 0; bj < 2; ++bj)
#pragma unroll
            for (int n = 0; n < 2; ++n) { const f32x4 bv = bias ? *(const f32x4*)(bias + col0 + bj * HALF + n * 16) : (f32x4){0.f, 0.f, 0.f, 0.f};
#pragma unroll
                for (int ai = 0; ai < 2; ++ai)
#pragma unroll
                    for (int m = 0; m < 4; ++m) acc[ai][bj][m][n] += bv; }
        bool bad = st1.run(acc, u, wr, wc, fr, fq, lds, wid, lane) || poison != 0u;
        const float qnan = __builtin_nanf("");
#pragma unroll
        for (int ai = 0; ai < 2; ++ai)
#pragma unroll
            for (int m = 0; m < 4; ++m) { const int r = ai * HALF + wr * 64 + m * 16 + fr; const f32x2v sr = S[r]; const size_t off = (size_t)(u.pm * BM + r) * ldc + col0;
#pragma unroll
                for (int bj = 0; bj < 2; ++bj)
#pragma unroll
                    for (int n = 0; n < 2; ++n) { const f32x4 bs = *(const f32x4*)(base + off + bj * HALF + n * 16); acc[ai][bj][m][n] = bs + (acc[ai][bj][m][n] - sr.x) * sr.y; }
                asm volatile("" : "+v"(acc[ai][0][m][0]), "+v"(acc[ai][0][m][1]), "+v"(acc[ai][1][m][0]), "+v"(acc[ai][1][m][1]));
                if (m & 1) asm volatile("" ::: "memory"); }
        const bool bad1 = bad;
        bad = st2.run(acc, u, wr, wc, fr, fq, lds, wid, lane) || bad;
#pragma unroll
        for (int ai = 0; ai < 2; ++ai)
#pragma unroll
            for (int m = 0; m < 4; ++m) { const int r = ai * HALF + wr * 64 + m * 16 + fr; const f32x2v sr = S[r]; const size_t off = (size_t)(u.pm * BM + r) * ldc + col0;
#pragma unroll
                for (int bj = 0; bj < 2; ++bj)
#pragma unroll
                    for (int n = 0; n < 2; ++n) { const f32x4 x1 = acc[ai][bj][m][n]; *(f32x4*)(out + off + bj * HALF + n * 16) = bad1 ? (f32x4){qnan, qnan, qnan, qnan} : x1;
                        const f32x4 o = (x1 - sr.x) * sr.y; u32x2v w; w.x = cvt_pk_bf16(o[0], o[1]); w.y = cvt_pk_bf16(o[2], o[3]);
                        if (bad) { w.x = 0x7fc07fc0u; w.y = 0x7fc07fc0u; } *(u32x2v*)(xn + off + bj * HALF + n * 16) = w; }
                asm volatile("" ::: "memory"); }
    }
};

template <class Epi, class Sched, bool STAMP = false, bool AOVL = false>
__device__ __forceinline__ void gemm_phase(PG8_LAS unsigned char* lds, const Gemm g, const Sched& S, const Epi& E, unsigned long long* stamps) {
    int tid_ = threadIdx.x; asm volatile("" : "+v"(tid_));
    const int tid = tid_, wid = __builtin_amdgcn_readfirstlane(tid >> 6), lane = tid & 63, wr = wid >> 2, wc = wid & 3, fr = lane & 15, fq = lane >> 4;
    const int K = g.K, nt = K / BK;
    int ts_lo = 0, ts_hi = 0, nts = 0; const unsigned long long rt_entry = STAMP ? (unsigned long long)wall_clock64() : 0ull;
#define PG8_STAMP() do { if (STAMP && wid == 0 && nts < 64) { const unsigned long long _c = (unsigned long long)clock64(); \
        ts_lo = (lane == nts) ? (int)(unsigned)_c : ts_lo; ts_hi = (lane == nts) ? (int)(unsigned)(_c >> 32) : ts_hi; ++nts; } } while (0)
    PG8_STAMP();
    unsigned voffA[2], voffB[2];
#pragma unroll
    for (int i = 0; i < 2; ++i) { int R, C; stage_rc(tid * 16 + i * 8192, R, C); const int Rb = Epi::PERM ? ((R & ~31) + perm32(R & 31)) : R;
        const int Ra = AOVL ? R - 2 * (R >> 6) : R;
        voffA[i] = (unsigned)(Ra * K + C) * 2u; voffB[i] = (unsigned)(Rb * K + C) * 2u; }
    const size_t kstep = (size_t)(BK * 2);
    const size_t hstep = (size_t)HALF * K * 2;
    const size_t tstep = 2 * hstep;
    const size_t hstepA = AOVL ? (size_t)124 * K * 2 : hstep, tstepA = 2 * hstepA;
    const unsigned ldsw = (unsigned)wid * 1024u;
    const int aoff = lds_byte(wr * 64 + fr, fq * 8), boff = lds_byte(wc * 32 + fr, fq * 8);
#define PG8_SA(b, h) (((b) * 2 + (h)) * HTB)
#define PG8_SB(b, h) ((4 + (b) * 2 + (h)) * HTB)
#define PG8_STAGE(bufoff, gbase, voff) do { _Pragma("unroll") for (int _i = 0; _i < 2; ++_i) \
        __builtin_amdgcn_global_load_lds((const unsigned*)((const char*)(gbase) + (voff)[_i]), (PG8_LAS unsigned*)(lds + (bufoff) + ldsw + _i * 8192), 16, 0, 0); } while (0)
#define PG8_LDA(dst, b, h) do { _Pragma("unroll") for (int m = 0; m < 4; ++m) _Pragma("unroll") for (int k = 0; k < 2; ++k) dst[m][k] = *(const PG8_LAS bf16x8*)(lds + PG8_SA(b, h) + aoff + m * 2048 + k * 1024); } while (0)
#define PG8_LDB(dst, b, h) do { _Pragma("unroll") for (int n = 0; n < 2; ++n) _Pragma("unroll") for (int k = 0; k < 2; ++k) dst[n][k] = *(const PG8_LAS bf16x8*)(lds + PG8_SB(b, h) + boff + n * 2048 + k * 1024); } while (0)
#define PG8_MMA(ai, bj, At, Bt) do { __builtin_amdgcn_s_setprio(1); _Pragma("unroll") for (int m = 0; m < 4; ++m) _Pragma("unroll") for (int n = 0; n < 2; ++n) _Pragma("unroll") for (int k = 0; k < 2; ++k) \
        acc[ai][bj][m][n] = __builtin_amdgcn_mfma_f32_16x16x32_bf16(Bt[n][k], At[m][k], acc[ai][bj][m][n], 0, 0, 0); __builtin_amdgcn_s_setprio(0); } while (0)
#define PG8_WAIT_V(n) asm volatile("s_waitcnt vmcnt(" #n ")" ::: "memory")
#define PG8_WAIT_L(n) asm volatile("s_waitcnt lgkmcnt(" #n ")" ::: "memory")
#define PG8_BAR __builtin_amdgcn_s_barrier()
#define PG8_SCHED __builtin_amdgcn_sched_barrier(0)
    Unit cur, nxt; int ui = 0;
    if (!S.next(0, cur)) return;
    f32x4 acc[2][2][4][2];
#pragma unroll
    for (int a = 0; a < 2; ++a)
#pragma unroll
        for (int b = 0; b < 2; ++b)
#pragma unroll
            for (int m = 0; m < 4; ++m)
#pragma unroll
                for (int n = 0; n < 2; ++n) acc[a][b][m][n] = (f32x4){0.f, 0.f, 0.f, 0.f};
    bf16x8 At[4][2], B0[2][2], B1[2][2];
    const char* cA = (const char*)g.A + (size_t)cur.pm * tstepA; const char* cB = (const char*)g.Bt + (size_t)cur.pn * tstep;
    S.a_ready(cur);
    PG8_STAGE(PG8_SB(0, 0), cB, voffB); PG8_STAGE(PG8_SA(0, 0), cA, voffA); PG8_STAGE(PG8_SB(0, 1), cB + hstep, voffB); PG8_STAGE(PG8_SA(0, 1), cA + hstepA, voffA);
    if (wr == 1) PG8_BAR;
    PG8_WAIT_V(4); PG8_BAR;
    PG8_STAGE(PG8_SB(1, 0), cB + kstep, voffB); PG8_STAGE(PG8_SA(1, 0), cA + kstep, voffA); PG8_STAGE(PG8_SB(1, 1), cB + hstep + kstep, voffB);
    PG8_WAIT_V(6); PG8_BAR;
    PG8_STAMP();
    for (;;) {
        const bool has_next = S.next(ui + 1, nxt);
        const char* nA = has_next ? (const char*)g.A + (size_t)nxt.pm * tstepA : cA; const char* nB = has_next ? (const char*)g.Bt + (size_t)nxt.pn * tstep : cB;
        for (int t = 0; t < nt; t += 2) {
            const bool last = (t == nt - 2);
            const char* a1 = cA + (size_t)(t + 1) * kstep;
            const char* a2 = last ? nA : cA + (size_t)(t + 2) * kstep; const char* b2 = last ? nB : cB + (size_t)(t + 2) * kstep;
            const char* a3 = a2 + kstep; const char* b3 = b2 + kstep;
            if (last && has_next) S.a_ready(nxt);
            PG8_LDB(B0, 0, 0); PG8_SCHED; PG8_LDA(At, 0, 0); PG8_STAGE(PG8_SA(1, 1), a1 + hstepA, voffA);
            PG8_WAIT_L(8); PG8_BAR; PG8_WAIT_L(0); PG8_MMA(0, 0, At, B0); PG8_BAR; PG8_SCHED;
            PG8_LDB(B1, 0, 1); PG8_STAGE(PG8_SB(0, 0), b2, voffB);
            PG8_BAR; PG8_WAIT_L(0); PG8_MMA(0, 1, At, B1); PG8_BAR;
            PG8_LDA(At, 0, 1); PG8_STAGE(PG8_SA(0, 0), a2, voffA);
            PG8_BAR; PG8_WAIT_L(0); PG8_MMA(1, 0, At, B0); PG8_BAR; PG8_SCHED;
            PG8_STAGE(PG8_SB(0, 1), b2 + hstep, voffB);
            PG8_WAIT_V(6); PG8_BAR; PG8_MMA(1, 1, At, B1); PG8_BAR;
            PG8_LDB(B0, 1, 0); PG8_SCHED; PG8_LDA(At, 1, 0); PG8_STAGE(PG8_SA(0, 1), a2 + hstepA, voffA);
            PG8_WAIT_L(8); PG8_BAR; PG8_WAIT_L(0); PG8_MMA(0, 0, At, B0); PG8_BAR; PG8_SCHED;
            PG8_LDB(B1, 1, 1); PG8_STAGE(PG8_SB(1, 0), b3, voffB);
            PG8_BAR; PG8_WAIT_L(0); PG8_MMA(0, 1, At, B1); PG8_BAR;
            PG8_LDA(At, 1, 1); PG8_STAGE(PG8_SA(1, 0), a3, voffA);
            PG8_BAR; PG8_WAIT_L(0); PG8_MMA(1, 0, At, B0); PG8_BAR; PG8_SCHED;
            PG8_STAGE(PG8_SB(1, 1), b3 + hstep, voffB);
            PG8_WAIT_V(6); PG8_BAR; PG8_MMA(1, 1, At, B1); PG8_BAR;
        }
        PG8_STAMP();
        if constexpr (!Epi::AFTER_DRAIN) { E(acc, cur, wr, wc, fr, fq); S.done(cur); }
        PG8_STAMP();
        if (!has_next) break;
#pragma unroll
        for (int a = 0; a < 2; ++a)
#pragma unroll
            for (int b = 0; b < 2; ++b)
#pragma unroll
                for (int m = 0; m < 4; ++m)
#pragma unroll
                    for (int n = 0; n < 2; ++n) acc[a][b][m][n] = (f32x4){0.f, 0.f, 0.f, 0.f};
        cur = nxt; cA = nA; cB = nB; ++ui;
    }
    PG8_WAIT_V(0);
    if (wr == 0) PG8_BAR;
    PG8_BAR;
    if constexpr (Epi::AFTER_DRAIN) { E.fused(acc, cur, wr, wc, fr, fq, lds, wid, lane); S.done(cur); }
    PG8_STAMP();
    if (STAMP && wid == 0) { stamps[lane] = lane < nts ? (((unsigned long long)(unsigned)ts_hi << 32) | (unsigned)ts_lo) : 0ull;
        if (lane == 62) stamps[62] = rt_entry; if (lane == 63) stamps[63] = (unsigned long long)wall_clock64(); }
#undef PG8_STAMP
#undef PG8_SA
#undef PG8_SB
#undef PG8_STAGE
#undef PG8_LDA
#undef PG8_LDB
#undef PG8_MMA
#undef PG8_WAIT_V
#undef PG8_WAIT_L
#undef PG8_BAR
#undef PG8_SCHED
}
}
namespace pg8 {
template <class T, class = void> struct keeps_acc { static constexpr bool v = false; };
template <class T> struct keeps_acc<T, decltype((void)T::KEEP_ACC)> { static constexpr bool v = T::KEEP_ACC; };
template <class Epi, class Sched, bool ALIGN_EPI = false, bool SP2 = false, bool AOVL = false>
__device__ __forceinline__ void gemm_phase2(PG8_LAS unsigned char* lds, const Gemm g, const Sched& S, const Epi& E) {
    int tid_ = threadIdx.x; asm volatile("" : "+v"(tid_));
    const int tid = tid_, wid = __builtin_amdgcn_readfirstlane(tid >> 6), lane = tid & 63, wr = wid >> 2, wc = wid & 3, fr = lane & 15, fq = lane >> 4;
    const int K = g.K, nt = K / BK;
    unsigned voffA[2], voffB[2];
#pragma unroll
    for (int i = 0; i < 2; ++i) { int R, C; stage_rc(tid * 16 + i * 8192, R, C); const int Rb = Epi::PERM ? ((R & ~31) + perm32(R & 31)) : R;
        const int Ra = AOVL ? R - 2 * (R >> 6) : R;
        voffA[i] = (unsigned)(Ra * K + C) * 2u; voffB[i] = (unsigned)(Rb * K + C) * 2u; }
    const size_t kstep = (size_t)(BK * 2);
    const size_t hstep = (size_t)HALF * K * 2;
    const size_t tstep = 2 * hstep;
    const size_t hstepA = AOVL ? (size_t)124 * K * 2 : hstep, tstepA = 2 * hstepA;
    const unsigned ldsw = (unsigned)wid * 1024u;
    const int aoff = lds_byte(wr * 64 + fr, fq * 8), boff = lds_byte(wc * 32 + fr, fq * 8);
#define PG8_SA(b, h) (((b) * 2 + (h)) * HTB)
#define PG8_SB(b, h) ((4 + (b) * 2 + (h)) * HTB)
#define PG8_STAGE(bufoff, gbase, voff) do { _Pragma("unroll") for (int _i = 0; _i < 2; ++_i) \
        __builtin_amdgcn_global_load_lds((const unsigned*)((const char*)(gbase) + (voff)[_i]), (PG8_LAS unsigned*)(lds + (bufoff) + ldsw + _i * 8192), 16, 0, 0); } while (0)
#define PG8_LDA(dst, b, h) do { _Pragma("unroll") for (int m = 0; m < 4; ++m) _Pragma("unroll") for (int k = 0; k < 2; ++k) dst[m][k] = *(const PG8_LAS bf16x8*)(lds + PG8_SA(b, h) + aoff + m * 2048 + k * 1024); } while (0)
#define PG8_LDB(dst, b, h) do { _Pragma("unroll") for (int n = 0; n < 2; ++n) _Pragma("unroll") for (int k = 0; k < 2; ++k) dst[n][k] = *(const PG8_LAS bf16x8*)(lds + PG8_SB(b, h) + boff + n * 2048 + k * 1024); } while (0)
#define PG8_MMA(ai, bj, At, Bt) do { __builtin_amdgcn_s_setprio(1); _Pragma("unroll") for (int m = 0; m < 4; ++m) _Pragma("unroll") for (int n = 0; n < 2; ++n) _Pragma("unroll") for (int k = 0; k < 2; ++k) \
        acc[ai][bj][m][n] = __builtin_amdgcn_mfma_f32_16x16x32_bf16(Bt[n][k], At[m][k], acc[ai][bj][m][n], 0, 0, 0); __builtin_amdgcn_s_setprio(0); } while (0)
#define PG8_WAIT_V(n) asm volatile("s_waitcnt vmcnt(" #n ")" ::: "memory")
#define PG8_WAIT_L(n) asm volatile("s_waitcnt lgkmcnt(" #n ")" ::: "memory")
#define PG8_BAR __builtin_amdgcn_s_barrier()
#define PG8_SCHED __builtin_amdgcn_sched_barrier(0)
    Unit cur, nxt; int ui = 0;
    if (!S.next(0, cur)) return;
    f32x4 acc[2][2][4][2];
#pragma unroll
    for (int a = 0; a < 2; ++a)
#pragma unroll
        for (int b = 0; b < 2; ++b)
#pragma unroll
            for (int m = 0; m < 4; ++m)
#pragma unroll
                for (int n = 0; n < 2; ++n) acc[a][b][m][n] = (f32x4){0.f, 0.f, 0.f, 0.f};
    bf16x8 At[4][2], B0[2][2], B1[2][2];
    const char* cA = (const char*)g.A + (size_t)cur.pm * tstepA; const char* cB = (const char*)g.Bt + (size_t)cur.pn * tstep;
    S.a_ready(cur);
    if constexpr (SP2) {
        PG8_STAGE(PG8_SB(0, 0), cB, voffB); PG8_STAGE(PG8_SB(0, 1), cB + hstep, voffB); PG8_STAGE(PG8_SA(0, 0), cA, voffA); PG8_STAGE(PG8_SA(0, 1), cA + hstepA, voffA);
        if (wr == 1) PG8_BAR;
        PG8_WAIT_V(2); PG8_BAR;
        PG8_STAGE(PG8_SB(1, 0), cB + kstep, voffB); PG8_STAGE(PG8_SA(1, 0), cA + kstep, voffA); PG8_STAGE(PG8_SB(1, 1), cB + hstep + kstep, voffB);
        PG8_WAIT_V(6); PG8_BAR;
    } else {
        PG8_STAGE(PG8_SB(0, 0), cB, voffB); PG8_STAGE(PG8_SA(0, 0), cA, voffA); PG8_STAGE(PG8_SB(0, 1), cB + hstep, voffB); PG8_STAGE(PG8_SA(0, 1), cA + hstepA, voffA);
        if (wr == 1) PG8_BAR;
        PG8_WAIT_V(4); PG8_BAR;
        PG8_STAGE(PG8_SB(1, 0), cB + kstep, voffB); PG8_STAGE(PG8_SA(1, 0), cA + kstep, voffA); PG8_STAGE(PG8_SB(1, 1), cB + hstep + kstep, voffB);
        PG8_WAIT_V(6); PG8_BAR;
    }
    for (;;) {
        const bool has_next = S.next(ui + 1, nxt);
        const char* nA = has_next ? (const char*)g.A + (size_t)nxt.pm * tstepA : cA; const char* nB = has_next ? (const char*)g.Bt + (size_t)nxt.pn * tstep : cB;
        for (int t = 0; t < nt; t += 2) {
            const bool last = (t == nt - 2);
            const char* a1 = cA + (size_t)(t + 1) * kstep;
            const char* a2 = last ? nA : cA + (size_t)(t + 2) * kstep; const char* b2 = last ? nB : cB + (size_t)(t + 2) * kstep;
            const char* a3 = a2 + kstep; const char* b3 = b2 + kstep;
            if (last && has_next) S.a_ready(nxt);
            if constexpr (SP2) {
            PG8_LDB(B0, 0, 0); PG8_LDB(B1, 0, 1); PG8_SCHED; PG8_LDA(At, 0, 0); PG8_STAGE(PG8_SA(1, 1), a1 + hstepA, voffA);
            PG8_WAIT_V(8); PG8_WAIT_L(0); PG8_BAR; PG8_MMA(0, 0, At, B0); PG8_MMA(0, 1, At, B1); PG8_BAR; PG8_SCHED;
            PG8_LDA(At, 0, 1); PG8_STAGE(PG8_SB(0, 0), b2, voffB); PG8_STAGE(PG8_SB(0, 1), b2 + hstep, voffB); PG8_STAGE(PG8_SA(0, 0), a2, voffA);
            PG8_WAIT_V(8); PG8_WAIT_L(0); PG8_BAR; PG8_MMA(1, 0, At, B0); PG8_MMA(1, 1, At, B1); PG8_BAR; PG8_SCHED;
            PG8_LDB(B0, 1, 0); PG8_LDB(B1, 1, 1); PG8_SCHED; PG8_LDA(At, 1, 0); PG8_STAGE(PG8_SA(0, 1), a2 + hstepA, voffA);
            PG8_WAIT_V(8); PG8_WAIT_L(0); PG8_BAR; PG8_MMA(0, 0, At, B0); PG8_MMA(0, 1, At, B1); PG8_BAR; PG8_SCHED;
            PG8_LDA(At, 1, 1); PG8_STAGE(PG8_SB(1, 0), b3, voffB); PG8_STAGE(PG8_SB(1, 1), b3 + hstep, voffB); PG8_STAGE(PG8_SA(1, 0), a3, voffA);
            PG8_WAIT_V(8); PG8_WAIT_L(0); PG8_BAR; PG8_MMA(1, 0, At, B0); PG8_MMA(1, 1, At, B1); PG8_BAR; PG8_SCHED;
            } else {
            PG8_LDB(B0, 0, 0); PG8_SCHED; PG8_LDA(At, 0, 0); PG8_STAGE(PG8_SA(1, 1), a1 + hstepA, voffA);
            PG8_WAIT_L(8); PG8_BAR; PG8_WAIT_L(0); PG8_MMA(0, 0, At, B0); PG8_BAR; PG8_SCHED;
            PG8_LDB(B1, 0, 1); PG8_STAGE(PG8_SB(0, 0), b2, voffB);
            PG8_BAR; PG8_WAIT_L(0); PG8_MMA(0, 1, At, B1); PG8_BAR;
            PG8_LDA(At, 0, 1); PG8_STAGE(PG8_SA(0, 0), a2, voffA);
            PG8_BAR; PG8_WAIT_L(0); PG8_MMA(1, 0, At, B0); PG8_BAR; PG8_SCHED;
            PG8_STAGE(PG8_SB(0, 1), b2 + hstep, voffB);
            PG8_WAIT_V(6); PG8_BAR; PG8_MMA(1, 1, At, B1); PG8_BAR;
            PG8_LDB(B0, 1, 0); PG8_SCHED; PG8_LDA(At, 1, 0); PG8_STAGE(PG8_SA(0, 1), a2 + hstepA, voffA);
            PG8_WAIT_L(8); PG8_BAR; PG8_WAIT_L(0); PG8_MMA(0, 0, At, B0); PG8_BAR; PG8_SCHED;
            PG8_LDB(B1, 1, 1); PG8_STAGE(PG8_SB(1, 0), b3, voffB);
            PG8_BAR; PG8_WAIT_L(0); PG8_MMA(0, 1, At, B1); PG8_BAR;
            PG8_LDA(At, 1, 1); PG8_STAGE(PG8_SA(1, 0), a3, voffA);
            PG8_BAR; PG8_WAIT_L(0); PG8_MMA(1, 0, At, B0); PG8_BAR; PG8_SCHED;
            PG8_STAGE(PG8_SB(1, 1), b3 + hstep, voffB);
            PG8_WAIT_V(6); PG8_BAR; PG8_MMA(1, 1, At, B1); PG8_BAR;
            }
        }
        if constexpr (ALIGN_EPI) { if (wr == 0) PG8_BAR; }
        if constexpr (!Epi::AFTER_DRAIN) { E(acc, cur, wr, wc, fr, fq); S.done(cur); }
        if (!has_next) break;
        bool keep_ = false; if constexpr (keeps_acc<Epi>::v) keep_ = E.keep(cur);
        if (!keep_) {
#pragma unroll
        for (int a = 0; a < 2; ++a)
#pragma unroll
            for (int b = 0; b < 2; ++b)
#pragma unroll
                for (int m = 0; m < 4; ++m)
#pragma unroll
                    for (int n = 0; n < 2; ++n) acc[a][b][m][n] = (f32x4){0.f, 0.f, 0.f, 0.f};
        }
        cur = nxt; cA = nA; cB = nB; ++ui;
        if constexpr (ALIGN_EPI) { if (wr == 1) PG8_BAR; }
    }
    PG8_WAIT_V(0);
    if constexpr (!ALIGN_EPI) { if (wr == 0) PG8_BAR; }
    PG8_BAR;
    if constexpr (Epi::AFTER_DRAIN) { E.fused(acc, cur, wr, wc, fr, fq, lds, wid, lane); S.done(cur); }
#undef PG8_SA
#undef PG8_SB
#undef PG8_STAGE
#undef PG8_LDA
#undef PG8_LDB
#undef PG8_MMA
#undef PG8_WAIT_V
#undef PG8_WAIT_L
#undef PG8_BAR
#undef PG8_SCHED
}

}
#define XB_TMO      128
#define XB_XCNT(j)  (256  + 64 * (j))
#define XB_XSUB(j)  (1280 + 64 * (j))
#define XB_XGEN(j)  (2304 + 64 * (j))
#define XB_TOP      3328
#define XB_TOPGEN   3392
#define XCD_BAR_WORDS 3456
#define XB_SPIN_CAP (1u << 22)
#define LAS __attribute__((address_space(3)))

__device__ __forceinline__ unsigned xb_ld(unsigned* p)              { return __hip_atomic_load(p, __ATOMIC_RELAXED, __HIP_MEMORY_SCOPE_AGENT); }
__device__ __forceinline__ unsigned xb_add(unsigned* p, unsigned v) { return __hip_atomic_fetch_add(p, v, __ATOMIC_RELAXED, __HIP_MEMORY_SCOPE_AGENT); }
__device__ __forceinline__ unsigned xb_xcc_id() { return (unsigned)__builtin_amdgcn_s_getreg((3 << 11) | 20) & 0xFu; }
#define XB_SPIN(cond, bar) do { unsigned _sp = 0; while (cond) { __builtin_amdgcn_s_sleep(1); \
    if ((++_sp & 255u) == 0u) { if (xb_ld(&(bar)[XB_TMO])) break; if (_sp > XB_SPIN_CAP) { atomicAdd(&(bar)[XB_TMO], 1u); break; } } } } while (0)

struct XcdBarrier {
    unsigned* bar; unsigned x;
    volatile LAS unsigned* st;
};

__device__ __forceinline__ XcdBarrier xcd_barrier_post(unsigned* bar, volatile LAS unsigned* st) {
    XcdBarrier b; b.bar = bar; b.x = xb_xcc_id(); b.st = st;
    if (threadIdx.x == 0) (void)xb_add(&bar[XB_XCNT(b.x)], 1u);
    return b;
}
__device__ __forceinline__ void xcd_barrier_complete(unsigned* bar, unsigned x, unsigned& nloc, unsigned& nx) {
    const unsigned G = gridDim.x * gridDim.y * gridDim.z;
    unsigned sum, cnt, mine, sp = 0u;
    for (;;) {
        sum = 0u; cnt = 0u; mine = 0u;
#pragma unroll
        for (unsigned j = 0; j < 16; ++j) { const unsigned c = xb_ld(&bar[XB_XCNT(j)]); sum += c; cnt += (c > 0u) ? 1u : 0u; mine = (j == x) ? c : mine; }
        if (sum == G) break;
        __builtin_amdgcn_s_sleep(1);
        if ((++sp & 255u) == 0u) { if (xb_ld(&bar[XB_TMO])) break; if (sp > XB_SPIN_CAP) { atomicAdd(&bar[XB_TMO], 1u); break; } }
    }
    nloc = mine > 0u ? mine : 1u; nx = cnt > 0u ? cnt : 1u;
}

__device__ __forceinline__ void xcd_barrier(const XcdBarrier& b) {
    asm volatile("s_waitcnt vmcnt(0)" ::: "memory");
    __syncthreads();
    if (threadIdx.x == 0) {
        unsigned* bar = b.bar;
        __builtin_amdgcn_s_waitcnt(0);
        unsigned nloc = b.st[0], nx = b.st[1];
        if (nloc == 0u) { xcd_barrier_complete(bar, b.x, nloc, nx); b.st[0] = nloc; b.st[1] = nx; }
        const unsigned old = xb_add(&bar[XB_XSUB(b.x)], 1u);
        const unsigned gen = old / nloc;
        if (old + 1u == (gen + 1u) * nloc) {
            __builtin_amdgcn_fence(__ATOMIC_RELEASE, "agent");
            asm volatile("s_waitcnt vmcnt(0)" ::: "memory");
            const unsigned og = xb_add(&bar[XB_TOP], 1u);
            const unsigned tg = og / nx;
            if (og + 1u == (tg + 1u) * nx) xb_add(&bar[XB_TOPGEN], 1u);
            else XB_SPIN(xb_ld(&bar[XB_TOPGEN]) == tg, bar);
            __builtin_amdgcn_fence(__ATOMIC_ACQUIRE, "agent");
            xb_add(&bar[XB_XGEN(b.x)], 1u);
            asm volatile("s_waitcnt vmcnt(0)" ::: "memory");
        } else {
            XB_SPIN(xb_ld(&bar[XB_XGEN(b.x)]) == gen, bar);
            __builtin_amdgcn_fence(__ATOMIC_ACQUIRE, "agent");
            asm volatile("s_waitcnt vmcnt(0)" ::: "memory");
        }
    }
    __syncthreads();
}

namespace mk {
typedef unsigned short bf16;
typedef unsigned v4u __attribute__((ext_vector_type(4)));
typedef unsigned v2u __attribute__((ext_vector_type(2)));
typedef float f32x4 __attribute__((ext_vector_type(4)));
typedef float f32x2 __attribute__((ext_vector_type(2)));

constexpr int S = 8192, D = 2048, NL = 4, NADA = 6 * D;
constexpr int NIN = 10776, ZLD = 11008, NUP = 11264, DFF = 5632;
constexpr int ZQ = 0, ZKC = 1024, ZVC = 1280, ZKS = 1536, ZVS = 1792, ZKW = 2048, ZVW = 2304, ZAG = 2560, ZQH = 2584, ZFH = 3608, ZIH = 4632, ZOG = 5656, ZMG = 6680;
constexpr int NCMP = 511, NSEL = 128, TOPK = 16, WINDOW = 512;
constexpr int HGC = 64, HGNC = S / HGC;
constexpr float EPS = 1e-6f;
constexpr float QSCALE = 0.08838834764831845f;
constexpr int KSPLIT = 8;

constexpr size_t MiB = 1u << 20;
constexpr size_t WS_CTL = 0, CTL_ZERO_BYTES = 64 * 1024;
constexpr size_t WS_ADAP = 1 * MiB;
constexpr size_t WS_ADA = 3 * MiB;
constexpr size_t WS_LB = 3 * MiB + 256 * 1024;
constexpr size_t WS_ROPE = 4 * MiB;
constexpr size_t WS_KCMP = 8 * MiB;
constexpr size_t WS_VCMP = 8 * MiB + 512 * 1024;
constexpr size_t WS_SELM = 10 * MiB;
constexpr size_t WS_HGD = 9 * MiB;
constexpr size_t WS_WIN = 16 * MiB;
constexpr size_t WS_WUP = 188 * MiB;
constexpr size_t WS_WDN = 364 * MiB;
constexpr size_t WS_WOUT = 452 * MiB;
constexpr size_t WS_WBA = 484 * MiB;
constexpr size_t WS_WBH = 500 * MiB;
constexpr size_t WS_H = 516 * MiB;
constexpr size_t WS_Z = 548 * MiB;
constexpr size_t WS_ATTN = 724 * MiB;
constexpr size_t WS_HG = 740 * MiB;
constexpr size_t WS_PART = 756 * MiB;
constexpr size_t WS_MIXED = 820 * MiB;
constexpr size_t WS_Y = 852 * MiB;
constexpr size_t WS_G = 916 * MiB;
constexpr size_t WS_HGS = 1004 * MiB;
constexpr size_t WS_WKC = 1068 * MiB;
constexpr size_t WS_WVC = 1072 * MiB;
constexpr size_t WS_PEBP = 1076 * MiB;
constexpr size_t WS_PEB = 1076 * MiB + 256 * 1024;
constexpr size_t WS_H2 = 1077 * MiB;
constexpr size_t WS_KVC = 1112 * MiB;
constexpr size_t WS_QR = 1128 * MiB;
constexpr size_t WS_KCR = 1144 * MiB;
constexpr size_t WS_HGS2 = 1148 * MiB;
constexpr size_t WS_END = 1212 * MiB;
constexpr int CW_BAR = 4096;

constexpr int RING_BYTES = 131072, LDS_BYTES = 155648, LDSCTL_OFF = LDS_BYTES - 512;

#ifndef REP_SELB
#define REP_SELB 1
#endif
#ifndef G2_ALIGN
#define G2_ALIGN true
#endif
#ifndef G2_SP2
#define G2_SP2 true
#endif
#ifndef GEMM_V2
#define GEMM_V2 1
#endif
#ifndef REP_BAR
#define REP_BAR 1
#endif
#ifndef DEFER_THR
#define DEFER_THR 8.0f
#endif
#ifndef REP_CMPB
#define REP_CMPB 1
#endif
#ifndef REP_WINB
#define REP_WINB 1
#endif
#ifndef REP_GZ
#define REP_GZ 1
#endif
#ifndef REP_GF
#define REP_GF 1
#endif
#ifndef REP_GG
#define REP_GG 1
#endif
#ifndef REP_GU
#define REP_GU 1
#endif
#ifndef REP_GD
#define REP_GD 1
#endif
#ifndef SEL_SPLIT
#define SEL_SPLIT 1
#endif
#ifndef HALF_PRIO
#define HALF_PRIO 0
#endif
#ifndef SEL_SKIP
#define SEL_SKIP 1
#endif
#ifndef DMA_LATE
#define DMA_LATE 1
#endif
#ifndef REP_QK
#define REP_QK 1
#endif
#ifndef SEL_PVF
#define SEL_PVF false
#endif
#ifndef WIN_PVF
#define WIN_PVF false
#endif
#ifndef PVF_EARLYV
#define PVF_EARLYV 0
#endif
#ifndef SEL_PVF2
#define SEL_PVF2 false
#endif
#ifndef QK_DB
#define QK_DB 0
#endif
#ifndef HG_DYN
#define HG_DYN 1
#endif
#ifndef NGZ
#define NGZ 256
#endif
#ifndef RES_BF16
#define RES_BF16 0
#endif
#ifndef ROW_NR
#define ROW_NR 4
#endif
#ifndef BR_CARRY
#define BR_CARRY 1
#endif
#ifndef IDLE_MUL
#define IDLE_MUL 1
#endif
#ifndef PV_DB
#define PV_DB 1
#endif
#ifndef REP_ROPE
#define REP_ROPE 1
#endif
#ifndef REP_P2
#define REP_P2 1
#endif
#ifndef REP_ROWPRE
#define REP_ROWPRE 0
#endif
#ifndef REP_P0
#define REP_P0 1
#endif
#ifndef REP_CMPR
#define REP_CMPR 1
#endif
#ifndef REP_P1
#define REP_P1 1
#endif
#ifndef REP_CONV
#define REP_CONV 1
#endif
#define LDS_WAIT() asm volatile("s_waitcnt lgkmcnt(0)" ::: "memory")

__device__ __forceinline__ float bf2f(unsigned v) { return __uint_as_float(v << 16); }
__device__ __forceinline__ float bflo(unsigned w) { return __uint_as_float(w << 16); }
__device__ __forceinline__ float bfhi(unsigned w) { return __uint_as_float(w & 0xffff0000u); }
typedef __bf16 bf16x2_t __attribute__((ext_vector_type(2)));
__device__ __forceinline__ unsigned pk2(float lo, float hi) { const f32x2 v = {lo, hi}; return __builtin_bit_cast(unsigned, __builtin_convertvector(v, bf16x2_t)); }
__device__ __forceinline__ unsigned f2bf(float f) { return pk2(f, 0.f) & 0xffffu; }
__device__ __forceinline__ float wave_sum(float v) {
#pragma unroll
    for (int o = 1; o < 64; o <<= 1) v += __shfl_xor(v, o);
    return v;
}
__device__ __forceinline__ float wave_max(float v) {
#pragma unroll
    for (int o = 1; o < 64; o <<= 1) v = fmaxf(v, __shfl_xor(v, o));
    return v;
}
__device__ __forceinline__ float sigmoidf_(float x) { return __builtin_amdgcn_rcpf(1.0f + __expf(-x)); }
__device__ __forceinline__ float siluf_(float x) { return x * __builtin_amdgcn_rcpf(1.0f + __expf(-x)); }

struct Args { const float* in[23]; float* out; unsigned char* ws; int ph_lo, ph_hi; };

struct Frame {
    LAS unsigned char* lds;
    int tid, lane, wave, G, bid;
    unsigned char* ws;
    float* out;
};
__device__ __forceinline__ const float* inp(const Frame& F, int k) {
    const unsigned long long v = ((const LAS unsigned long long*)(F.lds + LDSCTL_OFF + 128))[k];
    const unsigned lo = __builtin_amdgcn_readfirstlane((unsigned)v), hi = __builtin_amdgcn_readfirstlane((unsigned)(v >> 32));
    return (const float*)(((unsigned long long)hi << 32) | lo);
}

template <bool UPPERM = false>
__device__ __forceinline__ void tr_item(const float* W, int K, int N, int Npad, bf16* WT, LAS float* scr, int item, int lane) {
    const int nblk = Npad / 64, kb = item / nblk, nb = item % nblk, k0 = 64 * kb, n0 = 64 * nb;
    const int ns0 = UPPERM ? ((n0 & 255) >> 7) * DFF + (n0 >> 8) * 128 + (n0 & 127) : n0;
    const int kq = lane >> 4, n4 = 4 * (lane & 15);
    const bool ok = ns0 + n4 < N;
    f32x4 tv[16];
#pragma unroll
    for (int i = 0; i < 16; ++i) tv[i] = ok ? *(const f32x4*)(W + (size_t)(k0 + 4 * i + kq) * N + ns0 + n4) : (f32x4){0.f, 0.f, 0.f, 0.f};
#pragma unroll
    for (int i = 0; i < 16; ++i) { LAS float* d = scr + (4 * i + kq) * 65 + n4; d[0] = tv[i].x; d[1] = tv[i].y; d[2] = tv[i].z; d[3] = tv[i].w; }
    LDS_WAIT(); asm volatile("" ::: "memory");
    const int c = lane & 7;
#pragma unroll
    for (int j = 0; j < 8; ++j) { const int n = (lane >> 3) + 8 * j; const LAS float* sp = scr + (8 * c) * 65 + n;
        v4u o; o.x = pk2(sp[0 * 65], sp[1 * 65]); o.y = pk2(sp[2 * 65], sp[3 * 65]); o.z = pk2(sp[4 * 65], sp[5 * 65]); o.w = pk2(sp[6 * 65], sp[7 * 65]);
        *(v4u*)(WT + (size_t)(n0 + n) * K + k0 + 8 * c) = o; }
    LDS_WAIT(); asm volatile("" ::: "memory");
}

constexpr int I_IN = (D / 64) * (ZLD / 64), I_UP = (D / 64) * (NUP / 64), I_DN = (DFF / 64) * (D / 64), I_OUT = (D / 64) * (D / 64), I_BR = (1024 / 64) * (D / 64), I_CW = (4096 / 64) * (128 / 64);
constexpr int I_LAYER = I_IN + I_UP + I_DN + I_OUT + 2 * I_BR + 2 * I_CW;
#ifndef CONV_AHEAD
#define CONV_AHEAD 1
#endif
__device__ __forceinline__ void conv_item(Frame& F, int l, int r, LAS float* scr) {
    if (r < I_IN) { tr_item(inp(F, 6) + (size_t)l * D * NIN, D, NIN, ZLD, (bf16*)(F.ws + WS_WIN) + (size_t)l * ZLD * D, scr, r, F.lane); return; } r -= I_IN;
    if (r < I_UP) { tr_item<true>(inp(F, 18) + (size_t)l * D * NUP, D, NUP, NUP, (bf16*)(F.ws + WS_WUP) + (size_t)l * NUP * D, scr, r, F.lane); return; } r -= I_UP;
    if (r < I_DN) { tr_item(inp(F, 21) + (size_t)l * DFF * D, DFF, D, D, (bf16*)(F.ws + WS_WDN) + (size_t)l * D * DFF, scr, r, F.lane); return; } r -= I_DN;
    if (r < I_OUT) { tr_item(inp(F, 15) + (size_t)l * D * D, D, D, D, (bf16*)(F.ws + WS_WOUT) + (size_t)l * D * D, scr, r, F.lane); return; } r -= I_OUT;
    if (r < I_BR) { tr_item(inp(F, 13) + (size_t)l * 1024 * D, 1024, D, D, (bf16*)(F.ws + WS_WBA) + (size_t)l * 2 * D * 1024, scr, r, F.lane); return; } r -= I_BR;
    if (r < I_BR) { tr_item(inp(F, 14) + (size_t)l * 1024 * D, 1024, D, D, (bf16*)(F.ws + WS_WBA) + (size_t)(l * 2 + 1) * D * 1024, scr, r, F.lane); return; } r -= I_BR;
    if (r < I_CW) { tr_item(inp(F, 8) + (size_t)l * 4096 * 128, 4096, 128, 128, (bf16*)(F.ws + WS_WKC) + (size_t)l * 128 * 4096, scr, r, F.lane); return; } r -= I_CW;
    tr_item(inp(F, 10) + (size_t)l * 4096 * 128, 4096, 128, 128, (bf16*)(F.ws + WS_WVC) + (size_t)l * 128 * 4096, scr, r, F.lane);
}
__device__ __forceinline__ void convert_queue(Frame& F, int l) {
    unsigned* qw = (unsigned*)(F.ws + WS_CTL) + 2048 + 64 * l;
    LAS unsigned* slot = (LAS unsigned*)(F.lds + LDSCTL_OFF + 64);
    LAS float* scr = (LAS float*)(F.lds + F.wave * 17408);
    for (;;) {
        if (F.tid == 0) *slot = __hip_atomic_fetch_add(qw, 32u, __ATOMIC_RELAXED, __HIP_MEMORY_SCOPE_AGENT);
        __syncthreads();
        const unsigned base = *slot;
        __syncthreads();
        if (base >= (unsigned)I_LAYER) break;
#pragma unroll 1
        for (int i = 0; i < 4; ++i) { const int r = (int)base + i * 8 + F.wave; if (r < I_LAYER) conv_item(F, l, r, scr); }
    }
}
__device__ __forceinline__ void p0_prologue(Frame& F) {
    const int gtid = F.bid * 512 + F.tid, NT = F.G * 512;
    {
        LAS float* cact = (LAS float*)F.lds;
        for (int k = F.tid; k < D; k += 512) cact[k] = siluf_(inp(F, 1)[k]);
        __syncthreads();
        const float* w_ada = inp(F, 3);
        float* part = (float*)(F.ws + WS_ADAP);
        for (int idx = gtid; idx < KSPLIT * NL * (NADA / 4); idx += NT) {
            const int ks = idx / (NL * (NADA / 4)), rem = idx % (NL * (NADA / 4)), l = rem / (NADA / 4), col = 4 * (rem % (NADA / 4));
            const float* wp = w_ada + ((size_t)l * D + (size_t)ks * (D / KSPLIT)) * NADA + col;
            f32x4 acc = {0.f, 0.f, 0.f, 0.f};
#pragma unroll 16
            for (int k = 0; k < D / KSPLIT; ++k) { const f32x4 w = *(const f32x4*)(wp + (size_t)k * NADA); acc += w * cact[ks * (D / KSPLIT) + k]; }
            *(f32x4*)(part + (size_t)(ks * NL + l) * NADA + col) = acc;
        }
        __syncthreads();
    }
    {
        float* ct = (float*)(F.ws + WS_ROPE); float* st = ct + (size_t)S * 64;
        const int* pos = (const int*)inp(F, 2);
        for (int idx = gtid; idx < S * 64; idx += NT) {
            const int t = idx >> 6, i = idx & 63;
            const float invf = 1.0f / __builtin_powf(10000.0f, (float)(2 * i) / 128.0f);
            const float angf = (float)pos[t] * invf;
            const double a = (double)angf;
            const double q = __builtin_rint(a * 0.63661977236758134308);
            const double r = (a - q * 1.57079632679489655800) - q * 6.12323399573676603587e-17;
            const double r2 = r * r;
            double sp = -2.50521083854417187751e-08; sp = sp * r2 + 2.75573192239858906526e-06; sp = sp * r2 - 1.98412698412698412698e-04; sp = sp * r2 + 8.33333333333333333333e-03; sp = sp * r2 - 1.66666666666666666667e-01;
            const double sr = r + r * r2 * sp;
            double cp = 2.08767569878680989792e-09; cp = cp * r2 - 2.75573192239858906526e-07; cp = cp * r2 + 2.48015873015873015873e-05; cp = cp * r2 - 1.38888888888888888889e-03; cp = cp * r2 + 4.16666666666666666667e-02; cp = cp * r2 - 0.5;
            const double cr = 1.0 + r2 * cp;
            const int qi = ((int)(long long)q) & 3;
            const double sv = (qi == 0) ? sr : (qi == 1) ? cr : (qi == 2) ? -sr : -cr;
            const double cv = (qi == 0) ? cr : (qi == 1) ? -sr : (qi == 2) ? -cr : sr;
            ct[idx] = (float)cv; st[idx] = (float)sv;
        }
    }
    for (int i = gtid; i < 2 * D / 8; i += NT) ((v4u*)(F.ws + WS_H2))[i] = (v4u){0u, 0u, 0u, 0u};
    {
        float* lb = (float*)(F.ws + WS_LB); const float* lg = inp(F, 11);
        for (int c = gtid; c < 1024; c += NT) {
            float v[NL], m = -1e30f;
#pragma unroll
            for (int l = 0; l < NL; ++l) { v[l] = lg[l * 1024 + c]; m = fmaxf(m, v[l]); }
            float s = 0.f;
#pragma unroll
            for (int l = 0; l < NL; ++l) { v[l] = expf(v[l] - m); s += v[l]; }
            float run = 0.f;
#pragma unroll
            for (int l = 0; l < NL; ++l) { lb[l * 1024 + c] = run; if (l + 1 < NL) run += v[l + 1] / s; }
        }
    }
    {
        LAS float* scr = (LAS float*)(F.lds + 8192 + F.wave * 17408);
        const int gw = F.bid * 8 + F.wave, NGW = F.G * 8;
        for (int it = gw; it < (CONV_AHEAD ? 1 : NL) * I_LAYER; it += NGW) conv_item(F, it / I_LAYER, it % I_LAYER, scr);
    }
    {
        const int gtid = F.bid * 512 + F.tid, NT = F.G * 512;
        for (int idx = gtid; idx < NL * 2 * 32 * 128; idx += NT) {
            const int j = idx & 127, ks = (idx >> 7) & 31, lk = idx >> 12, l = lk >> 1, kv = lk & 1;
            const float* pe = (kv ? inp(F, 9) : inp(F, 7)) + (size_t)l * 4096 + ks * 128;
            const float* w = (kv ? inp(F, 10) : inp(F, 8)) + ((size_t)l * 4096 + ks * 128) * 128 + j;
            float acc = 0.f;
#pragma unroll 8
            for (int k = 0; k < 128; ++k) acc += pe[k] * w[(size_t)k * 128];
            ((float*)(F.ws + WS_PEBP))[idx] = acc;
        }
    }
}
__device__ __forceinline__ void p0b_ada(Frame& F) {
    const int gtid = F.bid * 512 + F.tid, NT = F.G * 512;
    const float* part = (const float*)(F.ws + WS_ADAP); float* ada = (float*)(F.ws + WS_ADA);
    for (int j = gtid; j < NL * NADA; j += NT) { float s = inp(F, 4)[j];
#pragma unroll
        for (int ks = 0; ks < KSPLIT; ++ks) s += part[(size_t)ks * NL * NADA + j];
        ada[j] = s; }
    for (int i = gtid; i < NL * 2 * 128; i += NT) { const int j = i & 127, lk = i >> 7; float s = 0.f;
        for (int ks = 0; ks < 32; ++ks) s += ((const float*)(F.ws + WS_PEBP))[(lk * 32 + ks) * 128 + j];
        ((float*)(F.ws + WS_PEB))[i] = s; }
}

template <bool POST, bool PRE, bool XIB = false, bool XOB = false>
__device__ __forceinline__ void row_phase(Frame& F, const void* xin_, const bf16* y, void* xout_, bf16* h,
                                          const float* gpost, const float* gt, const float* gpre, const float* sc, const float* sh) {
    const float* xin = (const float*)xin_; const bf16* xinb = (const bf16*)xin_; float* xout = (float*)xout_; bf16* xoutb = (bf16*)xout_;
    const int gw = F.bid * 8 + F.wave, NGW = F.G * 8, lane = F.lane;
    f32x4 xa[8], xb[8]; v2u ya[8], yb[8];
#define RP_LOAD(X_, Y_, r_) do { _Pragma("unroll") for (int j = 0; j < 8; ++j) { \
        if (XIB) { const v2u a_ = *(const v2u*)(xinb + (size_t)(r_) * D + 4 * lane + 256 * j); X_[j] = (f32x4){bflo(a_.x), bfhi(a_.x), bflo(a_.y), bfhi(a_.y)}; } \
        else X_[j] = *(const f32x4*)(xin + (size_t)(r_) * D + 4 * lane + 256 * j); \
        if (POST) Y_[j] = *(const v2u*)(y + (size_t)(r_) * D + 4 * lane + 256 * j); } } while (0)
#define RP_PROC(X_, Y_, row) do { \
        f32x4 x[8]; \
        _Pragma("unroll") for (int j = 0; j < 8; ++j) x[j] = X_[j]; \
        if (POST) { \
            f32x4 yv[8]; float ss = 0.f; \
            _Pragma("unroll") for (int j = 0; j < 8; ++j) { const v2u yw = Y_[j]; yv[j] = (f32x4){bflo(yw.x), bfhi(yw.x), bflo(yw.y), bfhi(yw.y)}; \
                ss += (yv[j].x * yv[j].x + yv[j].y * yv[j].y) + (yv[j].z * yv[j].z + yv[j].w * yv[j].w); } \
            const float r1s = 1.0f / sqrtf(wave_sum(ss) * (1.0f / D) + EPS); \
            _Pragma("unroll") for (int j = 0; j < 8; ++j) { const f32x4 g = *(const f32x4*)(gpost + 4 * lane + 256 * j), a = *(const f32x4*)(gt + 4 * lane + 256 * j); \
                x[j] = x[j] + a * ((yv[j] * r1s) * g); \
                if (XOB) { v2u w; w.x = pk2(x[j].x, x[j].y); w.y = pk2(x[j].z, x[j].w); *(v2u*)(xoutb + (size_t)(row) * D + 4 * lane + 256 * j) = w; } \
                else *(f32x4*)(xout + (size_t)(row) * D + 4 * lane + 256 * j) = x[j]; } \
        } \
        if (PRE) { \
            float ss = 0.f; \
            _Pragma("unroll") for (int j = 0; j < 8; ++j) ss += (x[j].x * x[j].x + x[j].y * x[j].y) + (x[j].z * x[j].z + x[j].w * x[j].w); \
            const float r2 = 1.0f / sqrtf(wave_sum(ss) * (1.0f / D) + EPS); \
            _Pragma("unroll") for (int j = 0; j < 8; ++j) { const f32x4 g = *(const f32x4*)(gpre + 4 * lane + 256 * j), a = *(const f32x4*)(sc + 4 * lane + 256 * j), b = *(const f32x4*)(sh + 4 * lane + 256 * j); \
                const f32x4 o = ((x[j] * r2) * g) * (a + 1.0f) + b; \
                v2u w; w.x = pk2(o.x, o.y); w.y = pk2(o.z, o.w); \
                *(v2u*)(h + (size_t)(row) * D + 4 * lane + 256 * j) = w; } \
        } } while (0)
    if (gw < S) RP_LOAD(xa, ya, gw);
    if (gw + NGW < S) RP_LOAD(xb, yb, gw + NGW);
    for (int row0 = gw; row0 < S; row0 += 2 * NGW) {
        RP_PROC(xa, ya, row0);
        if (row0 + 2 * NGW < S) RP_LOAD(xa, ya, row0 + 2 * NGW);
        if (row0 + NGW < S) {
            RP_PROC(xb, yb, row0 + NGW);
            if (row0 + 3 * NGW < S) RP_LOAD(xb, yb, row0 + 3 * NGW);
        }
    }
#undef RP_PROC
#undef RP_LOAD
}

__device__ __forceinline__ void phase_c(Frame& F, int l) {
    const int gtid = F.bid * 512 + F.tid, NT = F.G * 512, lane = F.lane;
    bf16* z = (bf16*)(F.ws + WS_Z);
    const float* ct = (const float*)(F.ws + WS_ROPE); const float* st = ct + (size_t)S * 64;
    for (int rep_ = 0; rep_ < REP_ROPE; ++rep_)
    for (int idx = gtid; idx < S * 112; idx += NT) {
        const int t = idx / 112, r = idx % 112, hd = r >> 3, ch = r & 7;
        const int col = hd < 8 ? ZQ + hd * 128 : (hd < 10 ? ZKS + (hd - 8) * 128 : (hd < 12 ? ZKW + (hd - 10) * 128 : ZKC + (hd - 12) * 128));
        bf16* p1 = z + (size_t)t * ZLD + col + 8 * ch; bf16* p2 = p1 + 64;
        const v4u a = *(const v4u*)p1, b = *(const v4u*)p2;
        const f32x4 c0 = *(const f32x4*)(ct + (size_t)t * 64 + 8 * ch), c1 = *(const f32x4*)(ct + (size_t)t * 64 + 8 * ch + 4);
        const f32x4 s0 = *(const f32x4*)(st + (size_t)t * 64 + 8 * ch), s1 = *(const f32x4*)(st + (size_t)t * 64 + 8 * ch + 4);
        v4u oa, ob;
        const float cs8[8] = {c0.x, c0.y, c0.z, c0.w, c1.x, c1.y, c1.z, c1.w}, sn8[8] = {s0.x, s0.y, s0.z, s0.w, s1.x, s1.y, s1.z, s1.w};
#pragma unroll
        for (int e = 0; e < 4; ++e) {
            const float x1l = bflo(a[e]), x1h = bfhi(a[e]), x2l = bflo(b[e]), x2h = bfhi(b[e]);
            const float cl = cs8[2 * e], chh = cs8[2 * e + 1], sl = sn8[2 * e], shh = sn8[2 * e + 1];
            oa[e] = pk2(x1l * cl - x2l * sl, x1h * chh - x2h * shh);
            ob[e] = pk2(x2l * cl + x1l * sl, x2h * chh + x1h * shh);
        }
        if (hd >= 8 && hd < 12) {
            bf16* o = (bf16*)(F.ws + WS_KVC) + ((size_t)((hd < 10 ? 0 : 2) * 2 + (hd & 1)) * S + t) * 128 + 8 * ch;
            *(v4u*)o = oa; *(v4u*)(o + 64) = ob;
        } else if (hd < 8) { bf16* o = (bf16*)(F.ws + WS_QR) + (size_t)t * 1024 + hd * 128 + 8 * ch; *(v4u*)o = oa; *(v4u*)(o + 64) = ob; }
        else { bf16* o = (bf16*)(F.ws + WS_KCR) + (size_t)t * 256 + (hd - 12) * 128 + 8 * ch; *(v4u*)o = oa; *(v4u*)(o + 64) = ob; }
    }
    for (int rep_ = 0; rep_ < REP_ROPE; ++rep_)
    for (int idx = gtid; idx < S * 64; idx += NT) {
        const int t = idx >> 6, r = idx & 63, which = r >> 4, ch = r & 15;
        const v4u v = *(const v4u*)(z + (size_t)t * ZLD + (which < 2 ? ZVS : ZVW) + (which & 1) * 128 + 8 * ch);
        *(v4u*)((bf16*)(F.ws + WS_KVC) + ((size_t)((which < 2 ? 1 : 3) * 2 + (which & 1)) * S + t) * 128 + 8 * ch) = v;
    }
}

__device__ __forceinline__ void compress_mfma(Frame& F, int l) {
    typedef short bf16x8 __attribute__((ext_vector_type(8)));
    const int lane = F.lane, w = F.wave, fr = lane & 15, fq = lane >> 4;
    const bf16* z = (const bf16*)(F.ws + WS_Z);
    LAS float* red = (LAS float*)F.lds;
    for (int it = F.bid; it < 64 * 4; it += F.G) {
        const int rt = it >> 2, kv = (it >> 1) & 1, nh = it & 1;
        const int r = 16 * rt + fr; int n = r >> 1; const int g = r & 1; if (n > NCMP - 1) n = NCMP - 1;
        const bf16* arow = kv ? z + (size_t)(16 * n) * ZLD + ZVC + g * 128 : (const bf16*)(F.ws + WS_KCR) + (size_t)(16 * n) * 256 + g * 128;
        const size_t apitch = kv ? (size_t)ZLD : (size_t)256;
        const bf16* wt = (const bf16*)(F.ws + (kv ? WS_WVC : WS_WKC)) + (size_t)l * 128 * 4096 + (size_t)(64 * nh) * 4096;
        pg8::f32x4 acc[4];
#pragma unroll
        for (int nt = 0; nt < 4; ++nt) acc[nt] = (pg8::f32x4){0.f, 0.f, 0.f, 0.f};
#pragma unroll 4
        for (int ks = 0; ks < 16; ++ks) {
            const int k0 = 32 * (16 * w + ks) + 8 * fq, pp = k0 >> 7, d = k0 & 127;
            const bf16x8 af = *(const bf16x8*)(arow + (size_t)pp * apitch + d);
#pragma unroll
            for (int nt = 0; nt < 4; ++nt) { const bf16x8 bfg = *(const bf16x8*)(wt + (size_t)(16 * nt + fr) * 4096 + k0);
                acc[nt] = __builtin_amdgcn_mfma_f32_16x16x32_bf16(af, bfg, acc[nt], 0, 0, 0); }
        }
#pragma unroll
        for (int nt = 0; nt < 4; ++nt)
#pragma unroll
            for (int e = 0; e < 4; ++e) red[(w * 16 + 4 * fq + e) * 64 + 16 * nt + fr] = acc[nt][e];
        __syncthreads();
        { const float* peb = (const float*)(F.ws + WS_PEB) + (l * 2 + kv) * 128 + 64 * nh;
          bf16* o = (bf16*)(F.ws + (kv ? WS_VCMP : WS_KCMP)) + 64 * nh;
          const int row = F.tid >> 5, c2 = (F.tid & 31) * 2;
          float s0 = peb[c2], s1 = peb[c2 + 1];
#pragma unroll
          for (int ww = 0; ww < 8; ++ww) { s0 += red[(ww * 16 + row) * 64 + c2]; s1 += red[(ww * 16 + row) * 64 + c2 + 1]; }
          const int rr = 16 * rt + row;
          *(unsigned*)(o + (size_t)rr * 128 + c2) = rr < NCMP * 2 ? pk2(s0, s1) : 0u; }
        __syncthreads();
    }
}

__device__ __forceinline__ void hgrn_pass2(Frame& F) {
    const int gtid = F.bid * 512 + F.tid, NT = F.G * 512;
    const unsigned* hgS = (const unsigned*)(F.ws + WS_HGS); unsigned* hgS2 = (unsigned*)(F.ws + WS_HGS2); const float* hgD = (const float*)(F.ws + WS_HGD);
    for (int e2 = gtid; e2 < 8 * 128 * 64; e2 += NT) {
        const int e = 2 * e2, hd = ((e >> 14) << 7) | (e & 127);
        float st0 = 0.f, st1 = 0.f;
        for (int c0 = 0; c0 < HGNC; c0 += 16) {
            unsigned u[16]; f32x2 dc[16];
#pragma unroll
            for (int i = 0; i < 16; ++i) { u[i] = hgS[(size_t)(c0 + i) * 65536 + e2]; dc[i] = *(const f32x2*)(hgD + (size_t)(c0 + i) * 1024 + hd); }
#pragma unroll
            for (int i = 0; i < 16; ++i) { hgS2[(size_t)(c0 + i) * 65536 + e2] = pk2(st0, st1); st0 = dc[i].x * st0 + bflo(u[i]); st1 = dc[i].y * st1 + bfhi(u[i]); }
        }
    }
}

namespace fa {
typedef short bf16x8 __attribute__((ext_vector_type(8)));
typedef short s16x4 __attribute__((ext_vector_type(4)));
typedef float f32x16 __attribute__((ext_vector_type(16)));
constexpr int SHM_T = 64 * 128 * 2;
constexpr float C2 = 1.4426950408889634f * QSCALE;
#define FA_KSWZ(row, colB) ((row) * 256 + ((colB) ^ (((row) & 7) << 4)))
__device__ __forceinline__ int v_st(int k, int c) { const int kk = (k & ~0xC) | ((k & 4) << 1) | ((k & 8) >> 1); return ((kk >> 3) * 4 + (c >> 5)) * 512 + ((kk & 7) * 32 + (c & 31)) * 2; }
__device__ __forceinline__ int v_rd_base(int lane) { return ((lane & 3) << 3) | (((lane >> 2) & 3) << 6) | (((lane >> 4) & 1) << 5) | (((lane >> 5) & 1) << 8); }
constexpr int v_rd_off(int d0, int ks, int half) { return d0 * 512 + ks * 4096 + half * 2048; }
__device__ __forceinline__ int crow(int r, int hi) { return (r & 3) + 8 * (r >> 2) + 4 * hi; }
__device__ __forceinline__ unsigned cvtpk(float lo, float hi) { return pk2(lo, hi); }
__device__ __forceinline__ void qkt(f32x16& p0, f32x16& p1, const LAS char* K_t, int r32, int hi, const bf16x8* qr) {
    p0 = f32x16{}; p1 = f32x16{};
    const LAS char* kb[4];
#pragma unroll
    for (int dd = 0; dd < 4; ++dd) kb[dd] = K_t + FA_KSWZ(r32, (dd * 16 + hi * 8) * 2);
#pragma unroll
    for (int d0 = 0; d0 < 8; ++d0) { const LAS char* a = kb[d0 & 3] + (d0 >> 2) * 128;
        const bf16x8 b0 = *reinterpret_cast<const LAS bf16x8*>(a);
        const bf16x8 b1 = *reinterpret_cast<const LAS bf16x8*>(a + 32 * 256);
        p0 = __builtin_amdgcn_mfma_f32_32x32x16_bf16(b0, qr[d0], p0, 0, 0, 0);
        p1 = __builtin_amdgcn_mfma_f32_32x32x16_bf16(b1, qr[d0], p1, 0, 0, 0); }
}
__device__ __forceinline__ void qkt_db(f32x16& p0, f32x16& p1, const LAS char* K_t, int r32, int hi, const bf16x8* qr) {
    p0 = f32x16{}; p1 = f32x16{};
    int ka[4];
#pragma unroll
    for (int dd = 0; dd < 4; ++dd) ka[dd] = (int)(unsigned)(size_t)(K_t + FA_KSWZ(r32, (dd * 16 + hi * 8) * 2));
#define FA_KRD(dst, a, off) asm volatile("ds_read_b128 %0, %1 offset:%2" : "=&v"(dst) : "v"(a), "i"(off) : "memory")
#define FA_KW(n, x, y) asm volatile("s_waitcnt lgkmcnt(" #n ")" : "+v"(x), "+v"(y) :: "memory")
#define FA_KMM(x, y, d0) do { p0 = __builtin_amdgcn_mfma_f32_32x32x16_bf16(x, qr[d0], p0, 0, 0, 0); p1 = __builtin_amdgcn_mfma_f32_32x32x16_bf16(y, qr[d0], p1, 0, 0, 0); } while (0)
    bf16x8 a0, a1, b0, b1;
    FA_KRD(a0, ka[0], 0); FA_KRD(a1, ka[0], 8192); FA_KRD(b0, ka[1], 0); FA_KRD(b1, ka[1], 8192);
    FA_KW(2, a0, a1); FA_KMM(a0, a1, 0); FA_KRD(a0, ka[2], 0); FA_KRD(a1, ka[2], 8192);
    FA_KW(2, b0, b1); FA_KMM(b0, b1, 1); FA_KRD(b0, ka[3], 0); FA_KRD(b1, ka[3], 8192);
    FA_KW(2, a0, a1); FA_KMM(a0, a1, 2); FA_KRD(a0, ka[0], 128); FA_KRD(a1, ka[0], 8320);
    FA_KW(2, b0, b1); FA_KMM(b0, b1, 3); FA_KRD(b0, ka[1], 128); FA_KRD(b1, ka[1], 8320);
    FA_KW(2, a0, a1); FA_KMM(a0, a1, 4); FA_KRD(a0, ka[2], 128); FA_KRD(a1, ka[2], 8320);
    FA_KW(2, b0, b1); FA_KMM(b0, b1, 5); FA_KRD(b0, ka[3], 128); FA_KRD(b1, ka[3], 8320);
    FA_KW(2, a0, a1); FA_KMM(a0, a1, 6);
    FA_KW(0, b0, b1); FA_KMM(b0, b1, 7);
#undef FA_KMM
#undef FA_KW
#undef FA_KRD
}
__device__ __forceinline__ void pv_tile(f32x16* o, int vb0, bf16x8 pa0, bf16x8 pa1, bf16x8 pa2, bf16x8 pa3) {
#define FA_TRRD(dst, off) asm volatile("ds_read_b64_tr_b16 %0, %1 offset:%2" : "=&v"(dst) : "v"(vb0), "i"(off) : "memory")
#define FA_PV_D0(d0) do { s16x4 l0, l1, l2, l3, h0, h1, h2, h3; constexpr int b_ = v_rd_off(d0, 0, 0); \
        FA_TRRD(l0, b_); FA_TRRD(h0, b_ + 2048); FA_TRRD(l1, b_ + 4096); FA_TRRD(h1, b_ + 6144); FA_TRRD(l2, b_ + 8192); FA_TRRD(h2, b_ + 10240); FA_TRRD(l3, b_ + 12288); FA_TRRD(h3, b_ + 14336); \
        asm volatile("s_waitcnt lgkmcnt(0)" ::: "memory"); __builtin_amdgcn_sched_barrier(0); \
        o[d0] = __builtin_amdgcn_mfma_f32_32x32x16_bf16(pa0, (bf16x8){l0[0], l0[1], l0[2], l0[3], h0[0], h0[1], h0[2], h0[3]}, o[d0], 0, 0, 0); \
        o[d0] = __builtin_amdgcn_mfma_f32_32x32x16_bf16(pa1, (bf16x8){l1[0], l1[1], l1[2], l1[3], h1[0], h1[1], h1[2], h1[3]}, o[d0], 0, 0, 0); \
        o[d0] = __builtin_amdgcn_mfma_f32_32x32x16_bf16(pa2, (bf16x8){l2[0], l2[1], l2[2], l2[3], h2[0], h2[1], h2[2], h2[3]}, o[d0], 0, 0, 0); \
        o[d0] = __builtin_amdgcn_mfma_f32_32x32x16_bf16(pa3, (bf16x8){l3[0], l3[1], l3[2], l3[3], h3[0], h3[1], h3[2], h3[3]}, o[d0], 0, 0, 0); } while (0)
    FA_PV_D0(0); FA_PV_D0(1); FA_PV_D0(2); FA_PV_D0(3);
#undef FA_PV_D0
#undef FA_TRRD
}
struct VSet { s16x4 l0, l1, l2, l3, h0, h1, h2, h3; };
template <int D0> __device__ __forceinline__ void v_issue(VSet& s, int vb0) {
#define FA_TRRD(dst, off) asm volatile("ds_read_b64_tr_b16 %0, %1 offset:%2" : "=&v"(dst) : "v"(vb0), "i"(off) : "memory")
    constexpr int b_ = v_rd_off(D0, 0, 0);
    FA_TRRD(s.l0, b_); FA_TRRD(s.h0, b_ + 2048); FA_TRRD(s.l1, b_ + 4096); FA_TRRD(s.h1, b_ + 6144); FA_TRRD(s.l2, b_ + 8192); FA_TRRD(s.h2, b_ + 10240); FA_TRRD(s.l3, b_ + 12288); FA_TRRD(s.h3, b_ + 14336);
#undef FA_TRRD
}
__device__ __forceinline__ void pv_mma(f32x16& o, const VSet& s, bf16x8 pa0, bf16x8 pa1, bf16x8 pa2, bf16x8 pa3) {
    o = __builtin_amdgcn_mfma_f32_32x32x16_bf16(pa0, (bf16x8){s.l0[0], s.l0[1], s.l0[2], s.l0[3], s.h0[0], s.h0[1], s.h0[2], s.h0[3]}, o, 0, 0, 0);
    o = __builtin_amdgcn_mfma_f32_32x32x16_bf16(pa1, (bf16x8){s.l1[0], s.l1[1], s.l1[2], s.l1[3], s.h1[0], s.h1[1], s.h1[2], s.h1[3]}, o, 0, 0, 0);
    o = __builtin_amdgcn_mfma_f32_32x32x16_bf16(pa2, (bf16x8){s.l2[0], s.l2[1], s.l2[2], s.l2[3], s.h2[0], s.h2[1], s.h2[2], s.h2[3]}, o, 0, 0, 0);
    o = __builtin_amdgcn_mfma_f32_32x32x16_bf16(pa3, (bf16x8){s.l3[0], s.l3[1], s.l3[2], s.l3[3], s.h3[0], s.h3[1], s.h3[2], s.h3[3]}, o, 0, 0, 0);
}
__device__ __forceinline__ void pv_tile_db(f32x16* o, int vb0, VSet& sA, bf16x8 pa0, bf16x8 pa1, bf16x8 pa2, bf16x8 pa3) {
    VSet sB;
    v_issue<1>(sB, vb0); asm volatile("s_waitcnt lgkmcnt(8)" ::: "memory"); __builtin_amdgcn_sched_barrier(0); pv_mma(o[0], sA, pa0, pa1, pa2, pa3);
    __builtin_amdgcn_sched_barrier(0);
    v_issue<2>(sA, vb0); asm volatile("s_waitcnt lgkmcnt(8)" ::: "memory"); __builtin_amdgcn_sched_barrier(0); pv_mma(o[1], sB, pa0, pa1, pa2, pa3);
    __builtin_amdgcn_sched_barrier(0);
    v_issue<3>(sB, vb0); asm volatile("s_waitcnt lgkmcnt(8)" ::: "memory"); __builtin_amdgcn_sched_barrier(0); pv_mma(o[2], sA, pa0, pa1, pa2, pa3);
    asm volatile("s_waitcnt lgkmcnt(0)" ::: "memory"); __builtin_amdgcn_sched_barrier(0); pv_mma(o[3], sB, pa0, pa1, pa2, pa3);
}
}

enum { BR_CMP2 = 0, BR_SEL = 1, BR_WIN = 2, BR_CMP1 = 3 };
struct FlashState { fa::f32x16 o[4]; float m, l; };
constexpr int FL_TAB = 8 * fa::SHM_T;
template <int MODE, bool EARLYV>
__device__ __forceinline__ void fb3_qksm(FlashState& St, const fa::bf16x8* qr, const LAS char* K_t, int vb0, fa::VSet& sA, fa::bf16x8& pa0, fa::bf16x8& pa1, fa::bf16x8& pa2, fa::bf16x8& pa3,
                                         int j, int tl, int cur, bool rowoff, LAS float* al_l, int r32, int hi, float mfix, float invl, LAS float* imp_row, LAS float* spill_row) {
    using namespace fa;
    const float NEG = -__builtin_inff();
    f32x16 p0, p1;
    if (QK_DB) qkt_db(p0, p1, K_t, r32, hi, qr); else qkt(p0, p1, K_t, r32, hi, qr);
#if REP_QK > 1
    for (int q_ = 1; q_ < REP_QK; ++q_) { asm volatile("" : "+v"(p0), "+v"(p1)); qkt(p0, p1, K_t, r32, hi, qr); }
#endif
    if (EARLYV && MODE != BR_CMP1) { __builtin_amdgcn_sched_barrier(0); v_issue<0>(sA, vb0); }
    const int kb = 64 * j;
    if (MODE == BR_WIN) {
#pragma unroll
        for (int r = 0; r < 16; ++r) { const int key = kb + (r & 3) + 8 * (r >> 2) + 4 * hi;
            if ((unsigned)(tl - key) >= (unsigned)WINDOW) p0[r] = NEG;
            if ((unsigned)(tl - key - 32) >= (unsigned)WINDOW) p1[r] = NEG; }
    } else if (MODE == BR_CMP1 || MODE == BR_CMP2) {
        const int nmax = (tl - 31) >> 4;
#pragma unroll
        for (int r = 0; r < 16; ++r) { const int key = kb + (r & 3) + 8 * (r >> 2) + 4 * hi;
            if (key > nmax) p0[r] = NEG;
            if (key + 32 > nmax) p1[r] = NEG; }
    } else {
        if (j == cur) {
#pragma unroll
            for (int r = 0; r < 16; ++r) { const int key = kb + (r & 3) + 8 * (r >> 2) + 4 * hi;
                if (key > tl) p0[r] = NEG;
                if (key + 32 > tl) p1[r] = NEG; }
        }
    }
    if (MODE == BR_CMP2) {
        const float mnL = -mfix * C2;
#pragma unroll
        for (int r = 0; r < 16; ++r) { p0[r] = __builtin_amdgcn_exp2f(fmaf(p0[r], C2, mnL)) * invl; p1[r] = __builtin_amdgcn_exp2f(fmaf(p1[r], C2, mnL)) * invl; }
        float own3[8], prt3[8];
#pragma unroll
        for (int i = 0; i < 4; ++i) { own3[i] = p0[4 * i + 3]; own3[4 + i] = p1[4 * i + 3]; }
#pragma unroll
        for (int i = 0; i < 8; ++i) { auto rr = __builtin_amdgcn_permlane32_swap(__float_as_uint(own3[i]), __float_as_uint(own3[i]), false, false); prt3[i] = __uint_as_float(hi ? rr[0] : rr[1]); }
#pragma unroll
        for (int i = 0; i < 8; ++i) {
            const float q0 = i < 4 ? p0[4 * i] : p1[4 * i - 16], q1 = i < 4 ? p0[4 * i + 1] : p1[4 * i - 15], q2 = i < 4 ? p0[4 * i + 2] : p1[4 * i - 14];
            const float prev = hi ? prt3[i] : (i > 0 ? prt3[i > 0 ? i - 1 : 0] : 0.f);
            float v = (q0 + q1) + (q2 + 0.5f * own3[i]) + 0.5f * prev;
            v += __shfl_xor(v, 1); v += __shfl_xor(v, 2);
            if ((r32 & 3) == 0) imp_row[16 * j + 2 * i + hi] = v;
        }
        { float sp = 0.5f * own3[7]; sp += __shfl_xor(sp, 1); sp += __shfl_xor(sp, 2); if ((r32 & 3) == 0 && hi == 1) spill_row[j + 1] = sp; }
    } else {
        float pmax = p0[0];
#pragma unroll
        for (int r = 1; r < 16; ++r) pmax = fmaxf(pmax, p0[r]);
#pragma unroll
        for (int r = 0; r < 16; ++r) pmax = fmaxf(pmax, p1[r]);
        if (MODE == BR_SEL) pmax = rowoff ? NEG : pmax;
        { auto rr = __builtin_amdgcn_permlane32_swap(__float_as_uint(pmax), __float_as_uint(pmax), false, false); pmax = fmaxf(__uint_as_float(rr[0]), __uint_as_float(rr[1])); }
        float mn, alpha;
        if (DEFER_THR > 0.f && __all((pmax - St.m) * C2 <= DEFER_THR)) { mn = St.m; alpha = 1.f; }
        else { mn = fmaxf(St.m, pmax); alpha = __builtin_amdgcn_exp2f((St.m - mn) * C2); St.m = mn; }
        float mnL = -mn * C2;
        if (MODE == BR_SEL) mnL = rowoff ? NEG : mnL;
        float ps = 0.f;
#pragma unroll
        for (int r = 0; r < 16; ++r) { p0[r] = __builtin_amdgcn_exp2f(fmaf(p0[r], C2, mnL)); ps += p0[r]; }
#pragma unroll
        for (int r = 0; r < 16; ++r) { p1[r] = __builtin_amdgcn_exp2f(fmaf(p1[r], C2, mnL)); ps += p1[r]; }
        { auto rr = __builtin_amdgcn_permlane32_swap(__float_as_uint(ps), __float_as_uint(ps), false, false); ps = __uint_as_float(rr[0]) + __uint_as_float(rr[1]); }
        St.l = St.l * alpha + ps;
        if (MODE != BR_CMP1 && __any(alpha < 1.f)) {
            if (hi == 0) al_l[r32] = alpha;
            asm volatile("s_waitcnt lgkmcnt(0)" ::: "memory");
            int h4 = 4 * hi; asm volatile("" : "+v"(h4));
            const LAS float* alb = al_l + h4;
#pragma unroll
            for (int r = 0; r < 16; ++r) { const float a = alb[(r & 3) + 8 * (r >> 2)];
#pragma unroll
                for (int d = 0; d < 4; ++d) St.o[d][r] *= a; }
            asm volatile("s_waitcnt lgkmcnt(0)" ::: "memory");
        }
    }
    if (MODE != BR_CMP1) {
#define FA_PK4(P, B_, OUT) do { unsigned a0 = cvtpk(P[B_ + 0], P[B_ + 1]), a1 = cvtpk(P[B_ + 2], P[B_ + 3]); \
        unsigned b0 = cvtpk(P[B_ + 4], P[B_ + 5]), b1 = cvtpk(P[B_ + 6], P[B_ + 7]); \
        auto r0 = __builtin_amdgcn_permlane32_swap(a0, b0, false, false); auto r1 = __builtin_amdgcn_permlane32_swap(a1, b1, false, false); \
        v4u w_ = {r0[0], r1[0], r0[1], r1[1]}; OUT = *reinterpret_cast<bf16x8*>(&w_); } while (0)
        FA_PK4(p0, 0, pa0); FA_PK4(p0, 8, pa1); FA_PK4(p1, 0, pa2); FA_PK4(p1, 8, pa3);
#undef FA_PK4
    }
}

template <int MODE, bool SHARED, int NST, bool KEEPH0 = false, bool PVF = false>
__device__ __forceinline__ void flash_branch3(FlashState& St, const fa::bf16x8* qr, const bf16* Kg, const bf16* Vg, size_t ld, int jf, int jl, int nsteps, int jclamp,
                                              LAS char* lds, LAS float* al_l, int tl, unsigned sw0, unsigned sw1, unsigned sw2, unsigned sw3, int cur,
                                              int w, int lane_in, float mfix = 0.f, float invl = 0.f, LAS float* imp_row = nullptr, LAS float* spill_row = nullptr) {
    using namespace fa;
    static_assert(!PVF || (MODE == BR_SEL || MODE == BR_WIN), "PVF: branches with a P V only");
    int lane = lane_in; asm volatile("" : "+v"(lane));
    const int r32 = lane & 31, hi = lane >> 5, wq = w & 3, half = w >> 2;
    constexpr int NP = SHARED ? 2 : 4;
    unsigned koff[2], voff0;
#pragma unroll
    for (int i = 0; i < 2; ++i) {
        const int cidx = SHARED ? w * 2 + i : wq * 4 + i;
        const int krow = cidx * 4 + (lane >> 4), kcolB = ((lane & 15) * 16) ^ ((krow & 7) << 4);
        koff[i] = (unsigned)((size_t)krow * ld * 2) + (unsigned)kcolB;
    }
    {
        const int cidx = SHARED ? w * 2 : wq * 4;
        const int sub = cidx * 2 + (lane >> 5), khi = sub >> 2, cblk = sub & 3, klo = (lane & 31) >> 2, cin = (lane & 3) * 8, kk = khi * 8 + klo;
        const int vk = (kk & ~0xC) | ((kk & 4) << 1) | ((kk & 8) >> 1), vc = cblk * 32 + cin;
        voff0 = (unsigned)((size_t)vk * ld * 2) + (unsigned)(vc * 2);
    }
    const int vlag = PVF ? (SHARED ? 1 : half) : 0;
#define FB3_STAGE(k) (lds + (SHARED ? (((k) + NST) & (NST - 1)) : (((k) & 1) * 2 + half)) * (2 * SHM_T))
#define FB3_ISSUE(k) do { int jt_ = jf + (k); jt_ = jt_ > jclamp ? jclamp : jt_; int jv_ = jf + (k) - vlag; jv_ = jv_ < jf ? jf : jv_; jv_ = jv_ > jclamp ? jclamp : jv_; \
        const char* kbase_ = (const char*)Kg + (size_t)(64 * jt_) * ld * 2; const char* vbase_ = (const char*)Vg + (size_t)(64 * jv_) * ld * 2; \
        LAS char* kt_ = FB3_STAGE(k) + (SHARED ? w * 2048 : wq * 4096); LAS char* vt_ = FB3_STAGE((k) - vlag) + SHM_T + (SHARED ? w * 2048 : wq * 4096); \
        _Pragma("unroll") for (int i_ = 0; i_ < NP; ++i_) { \
            __builtin_amdgcn_global_load_lds((const unsigned*)(kbase_ + (size_t)(i_ >> 1) * (8 * ld * 2) + koff[i_ & 1]), (LAS unsigned*)(kt_ + i_ * 1024), 16, 0, 0); \
            __builtin_amdgcn_global_load_lds((const unsigned*)(vbase_ + ((size_t)(i_ >> 1) * (4 * ld * 2) + (i_ & 1) * 128) + voff0), (LAS unsigned*)(vt_ + i_ * 1024), 16, 0, 0); } } while (0)
#define FB3_SYNC() do { if (NST == 4) { if (PVF) asm volatile("s_waitcnt vmcnt(4) lgkmcnt(0)" ::: "memory"); else asm volatile("s_waitcnt vmcnt(8) lgkmcnt(0)" ::: "memory"); } \
        else asm volatile("s_waitcnt vmcnt(0) lgkmcnt(0)" ::: "memory"); \
        __builtin_amdgcn_s_barrier(); asm volatile("" ::: "memory"); } while (0)
#define FB3_ACTIVE(j_, act_, roff_) do { act_ = (j_) <= jl; roff_ = false; \
        if (MODE == BR_SEL) { const unsigned swj_ = (j_) < 32 ? sw0 : ((j_) < 64 ? sw1 : ((j_) < 96 ? sw2 : sw3)); roff_ = ((swj_ >> ((j_) & 31)) & 1u) == 0u; \
            if (SEL_SKIP && __all(roff_)) act_ = false; } } while (0)
    if (!KEEPH0) {
#pragma unroll
        for (int d = 0; d < 4; ++d) St.o[d] = f32x16{};
        St.m = -1e30f; St.l = 0.f;
    } else {
        float kf = half == 0 ? 1.f : 0.f; asm volatile("" : "+v"(kf));
#pragma unroll
        for (int d = 0; d < 4; ++d) St.o[d] *= kf;
        St.m = half == 0 ? St.m : -1e30f; St.l *= kf;
    }
#pragma unroll
    for (int s_ = 0; s_ < NST - 1; ++s_) FB3_ISSUE(s_);
    if (HALF_PRIO && half == 0) __builtin_amdgcn_s_setprio(HALF_PRIO);
    if (!(PVF && half)) {
        for (int step = 0; step < nsteps; ++step) {
            FB3_SYNC();
            constexpr bool LATE = DMA_LATE != 0 && MODE != BR_CMP1 && NST == 4;
            if (!LATE) FB3_ISSUE(step + NST - 1);
            const int j = jf + step; bool active, rowoff; FB3_ACTIVE(j, active, rowoff);
            if (LATE && !active) FB3_ISSUE(step + NST - 1);
            if (active) {
                const LAS char* K_t = FB3_STAGE(step);
                const int vb0 = (int)(unsigned)(size_t)(K_t + SHM_T) + v_rd_base(lane);
                VSet sA; bf16x8 pa0, pa1, pa2, pa3;
                constexpr bool EV = PV_DB != 0 && !(PVF && !PVF_EARLYV);
                fb3_qksm<MODE, EV>(St, qr, K_t, vb0, sA, pa0, pa1, pa2, pa3, j, tl, cur, rowoff, al_l, r32, hi, mfix, invl, imp_row, spill_row);
                if (MODE != BR_CMP1) {
                    if (PV_DB) { __builtin_amdgcn_sched_barrier(0); if (!EV) { v_issue<0>(sA, vb0); __builtin_amdgcn_sched_barrier(0); } pv_tile_db(St.o, vb0, sA, pa0, pa1, pa2, pa3); } else pv_tile(St.o, vb0, pa0, pa1, pa2, pa3);
                }
                if (LATE) { __builtin_amdgcn_sched_barrier(0); FB3_ISSUE(step + NST - 1); }
            }
        }
        asm volatile("s_waitcnt vmcnt(0) lgkmcnt(0)" ::: "memory");
        __builtin_amdgcn_s_barrier(); asm volatile("" ::: "memory");
        if (PVF) { __builtin_amdgcn_s_barrier(); asm volatile("" ::: "memory"); }
    } else {
        bf16x8 pa0 = {}, pa1 = {}, pa2 = {}, pa3 = {}; bool pend = false; int vbp = 0;
        for (int step = 0; step < nsteps; ++step) {
            FB3_SYNC();
            FB3_ISSUE(step + NST - 1);
            if (pend) { VSet sA; v_issue<0>(sA, vbp); __builtin_amdgcn_sched_barrier(0); pv_tile_db(St.o, vbp, sA, pa0, pa1, pa2, pa3); }
            const int j = jf + step; bool active, rowoff; FB3_ACTIVE(j, active, rowoff);
            pend = active;
            if (active) {
                const LAS char* K_t = FB3_STAGE(step);
                vbp = (int)(unsigned)(size_t)(K_t + SHM_T) + v_rd_base(lane);
                VSet sU;
                fb3_qksm<MODE, false>(St, qr, K_t, vbp, sU, pa0, pa1, pa2, pa3, j, tl, cur, rowoff, al_l, r32, hi, mfix, invl, imp_row, spill_row);
            }
        }
        asm volatile("s_waitcnt vmcnt(0) lgkmcnt(0)" ::: "memory");
        __builtin_amdgcn_s_barrier(); asm volatile("" ::: "memory");
        if (pend) { VSet sA; v_issue<0>(sA, vbp); __builtin_amdgcn_sched_barrier(0); pv_tile_db(St.o, vbp, sA, pa0, pa1, pa2, pa3); }
        asm volatile("s_waitcnt lgkmcnt(0)" ::: "memory");
        __builtin_amdgcn_s_barrier(); asm volatile("" ::: "memory");
    }
    if (HALF_PRIO) __builtin_amdgcn_s_setprio(0);
#undef FB3_ACTIVE
#undef FB3_SYNC
#undef FB3_ISSUE
#undef FB3_STAGE
}

template <bool FIRST, bool LAST>
__device__ __forceinline__ void nsa3_finish(const FlashState& St, float scale, LAS float* al_l, float* accw  , bf16* outw, int lane_in) {
    int lane = lane_in; asm volatile("" : "+v"(lane));
    const int r32 = lane & 31, hi = lane >> 5;
    if (hi == 0) al_l[r32] = scale;
    asm volatile("s_waitcnt lgkmcnt(0)" ::: "memory");
    int h4 = 4 * hi; asm volatile("" : "+v"(h4));
    const LAS float* alb = al_l + h4;
    float* const abase = accw + hi * 1024 + r32; bf16* const obase = outw + hi * 1024 + r32;
#pragma unroll
    for (int r4 = 0; r4 < 16; r4 += 8) {
        float av[8][4];
#pragma unroll
        for (int rr = 0; rr < 8; ++rr) { const int r = r4 + rr, roff = (2 * (r >> 2)) * 1024 + (r & 3) * 128;
#pragma unroll
            for (int d = 0; d < 4; ++d) av[rr][d] = FIRST ? 0.f : abase[roff + d * 32]; }
#pragma unroll
        for (int rr = 0; rr < 8; ++rr) { const int r = r4 + rr, roff = (2 * (r >> 2)) * 1024 + (r & 3) * 128;
            const float sc = alb[(r & 3) + 8 * (r >> 2)];
#pragma unroll
            for (int d = 0; d < 4; ++d) {
                const float v = St.o[d][r] * sc + av[rr][d];
                if (LAST) { const float vn = __shfl_xor(v, 1); if ((r32 & 1) == 0) *(unsigned*)(obase + roff + d * 32) = fa::cvtpk(v, vn); }
                else abase[roff + d * 32] = v;
            } }
        asm volatile("" ::: "memory");
    }
    asm volatile("s_waitcnt lgkmcnt(0)" ::: "memory");
}

__device__ __forceinline__ void nsa3_merge(FlashState& St, float gate, LAS char* lds, LAS float* al_l, int w, int lane_in) {
    int lane = lane_in; asm volatile("" : "+v"(lane));
    const int r32 = lane & 31, hi = lane >> 5, wq = w & 3, half = w >> 2;
    LAS float* mrg = (LAS float*)lds + wq * 4096 + lane;
    LAS float* mlx = (LAS float*)(lds + 65536) + wq * 128;
    if (half) {
#pragma unroll
        for (int d = 0; d < 4; ++d)
#pragma unroll
            for (int r = 0; r < 16; ++r) mrg[(d * 16 + r) * 64] = St.o[d][r];
        if (hi == 0) { mlx[r32] = St.m; mlx[32 + r32] = St.l; }
    }
    asm volatile("s_waitcnt lgkmcnt(0)" ::: "memory"); __builtin_amdgcn_s_barrier(); asm volatile("" ::: "memory");
    if (!half) {
        const float m1 = mlx[r32], l1 = mlx[32 + r32];
        const float m = fmaxf(St.m, m1);
        const float e0 = __builtin_amdgcn_exp2f((St.m - m) * fa::C2), e1 = __builtin_amdgcn_exp2f((m1 - m) * fa::C2);
        const float lt = St.l * e0 + l1 * e1, sc = gate * (lt > 0.f ? 1.0f / lt : 0.f);
        if (hi == 0) { al_l[r32] = e0 * sc; mlx[64 + r32] = e1 * sc; }
        asm volatile("s_waitcnt lgkmcnt(0)" ::: "memory");
        int h4 = 4 * hi; asm volatile("" : "+v"(h4));
        const LAS float* a0b = al_l + h4; const LAS float* a1b = mlx + 64 + h4;
#pragma unroll
        for (int r = 0; r < 16; ++r) { const float a0 = a0b[(r & 3) + 8 * (r >> 2)], a1 = a1b[(r & 3) + 8 * (r >> 2)];
#pragma unroll
            for (int d = 0; d < 4; ++d) St.o[d][r] = St.o[d][r] * a0 + mrg[(d * 16 + r) * 64] * a1; }
    }
    asm volatile("s_waitcnt lgkmcnt(0)" ::: "memory"); __builtin_amdgcn_s_barrier(); asm volatile("" ::: "memory");
}

__device__ __forceinline__ void nsa3_phase(Frame& F, int l) {
    using namespace fa;
    const int tid = F.tid, lane = F.lane, w = F.wave, wq = w & 3, half = w >> 2, r32 = lane & 31, hi = lane >> 5;
    LAS char* lds = (LAS char*)F.lds;
    LAS float* al_l = (LAS float*)(lds + FL_TAB) + w * 32;
    LAS float* gate_l = (LAS float*)(lds + FL_TAB + 1024);
    LAS unsigned* selm = (LAS unsigned*)(gate_l + 768);
    LAS float* imp_l = (LAS float*)(lds + 4 * SHM_T);
    LAS float* spill_l = imp_l + 64 * 128;
    const bf16* kcmp = (const bf16*)(F.ws + WS_KCMP); const bf16* vcmp = (const bf16*)(F.ws + WS_VCMP);
    const bf16* z = (const bf16*)(F.ws + WS_Z);
    float* accb = (float*)(F.ws + WS_PART);
    bf16* attn = (bf16*)(F.ws + WS_ATTN);
    const bf16* kvc = (const bf16*)(F.ws + WS_KVC);
    for (int item = F.bid; item < 256; item += F.G) {
        const int g = item & 1, a = item >> 1;
        const int uu0 = 255 - a, uu1 = a, uu = half ? uu1 : uu0;
        const int t0 = 32 * uu, cur = t0 >> 6, cur0 = (32 * uu0) >> 6;
        const int tl = t0 + 8 * wq + (r32 >> 2), head = g * 4 + (r32 & 3);
        const int tokidx = half * 32 + 8 * wq + (r32 >> 2);
        bf16x8 qr[8];
#pragma unroll
        for (int d0 = 0; d0 < 8; ++d0) qr[d0] = *(const bf16x8*)((const bf16*)(F.ws + WS_QR) + (size_t)tl * 1024 + head * 128 + d0 * 16 + hi * 8);
        asm volatile("s_waitcnt lgkmcnt(0)" ::: "memory"); __builtin_amdgcn_s_barrier(); asm volatile("" ::: "memory");
        if (tid < 256) { const int row = tid, h_ = row >> 7, wq_ = (row >> 5) & 3, c_ = row & 31, tok = 32 * (h_ ? uu1 : uu0) + 8 * wq_ + (c_ >> 2), hh = g * 4 + (c_ & 3);
#pragma unroll
            for (int br = 0; br < 3; ++br) gate_l[br * 256 + row] = sigmoidf_(bf2f(z[(size_t)tok * ZLD + ZAG + hh * 3 + br])); }
        asm volatile("s_waitcnt lgkmcnt(0)" ::: "memory"); __builtin_amdgcn_s_barrier(); asm volatile("" ::: "memory");
        const int rowwg = half * 128 + wq * 32 + r32;
        float* const accw = accb + (size_t)(t0 + 8 * wq) * 1024 + g * 512; bf16* const outw = attn + (size_t)(t0 + 8 * wq) * 1024 + g * 512;
        FlashState St;
        {
            const int jlc = (t0 >> 4) >> 6, jlc0 = ((32 * uu0) >> 4) >> 6; float mfix = 0.f, invl = 0.f;
            for (int rep_ = 0; rep_ < REP_CMPB; ++rep_) {
            flash_branch3<BR_CMP1, true, 2>(St, qr, kcmp + g * 128, vcmp + g * 128, (size_t)256, 0, jlc, jlc0 + 1, jlc0, lds, al_l, tl, 0u, 0u, 0u, 0u, cur, w, lane);
            mfix = St.m; invl = St.l > 0.f ? 1.0f / St.l : 0.f;
            flash_branch3<BR_CMP2, true, 2>(St, qr, kcmp + g * 128, vcmp + g * 128, (size_t)256, 0, jlc, jlc0 + 1, jlc0, lds, al_l, tl, 0u, 0u, 0u, 0u, cur, w, lane, mfix, invl, imp_l + tokidx * 128, spill_l + tokidx * 9);
            }
            nsa3_finish<true, false>(St, gate_l[0 * 256 + rowwg], al_l, accw, outw, lane);
            {
                const int K = cur + 1 < TOPK ? cur + 1 : TOPK;
                LAS unsigned* keys = (LAS unsigned*)(lds + FL_TAB + 5120) + w * 128;
                for (int tt = 0; tt < 8; ++tt) {
                    const int tk = 8 * w + tt;
                    unsigned cv0, cv1;
                    { const int m = lane; float imp = 0.f; if (m <= cur) { imp = imp_l[tk * 128 + m]; if ((m & 15) == 0 && m > 0) imp += spill_l[tk * 9 + (m >> 4)]; }
                      const bool forced = (m == 0) || (m == cur) || (m == cur - 1); cv0 = (m > cur) ? 0u : (forced ? 0x7f800001u : __float_as_uint(imp) + 1u); }
                    { const int m = lane + 64; float imp = 0.f; if (m <= cur) { imp = imp_l[tk * 128 + m]; if ((m & 15) == 0) imp += spill_l[tk * 9 + (m >> 4)]; }
                      const bool forced = (m == cur) || (m == cur - 1); cv1 = (m > cur) ? 0u : (forced ? 0x7f800001u : __float_as_uint(imp) + 1u); }
                    keys[lane] = cv0; keys[lane + 64] = cv1;
                    asm volatile("s_waitcnt lgkmcnt(0)" ::: "memory");
                    const unsigned long long k0 = ((unsigned long long)cv0 << 8) | (unsigned)(255 - lane), k1 = ((unsigned long long)cv1 << 8) | (unsigned)(191 - lane);
                    int rk0 = 0, rk1 = 0;
                    const int mend = (cur + 4) & ~3;
                    for (int m4 = 0; m4 < mend; m4 += 4) { const v4u kq = *(const LAS v4u*)(keys + m4);
#pragma unroll
                        for (int e = 0; e < 4; ++e) { const unsigned long long ko = ((unsigned long long)kq[e] << 8) | (unsigned)(255 - (m4 + e));
                            rk0 += ko > k0 ? 1 : 0; rk1 += ko > k1 ? 1 : 0; } }
                    const unsigned long long b0 = __ballot(cv0 != 0u && rk0 < K), b1 = __ballot(cv1 != 0u && rk1 < K);
                    if (lane == 0) { selm[tk * 4 + 0] = (unsigned)b0; selm[tk * 4 + 1] = (unsigned)(b0 >> 32); selm[tk * 4 + 2] = (unsigned)b1; selm[tk * 4 + 3] = (unsigned)(b1 >> 32); }
                    asm volatile("s_waitcnt lgkmcnt(0)" ::: "memory");
                }
            }
            asm volatile("s_waitcnt lgkmcnt(0)" ::: "memory"); __builtin_amdgcn_s_barrier(); asm volatile("" ::: "memory");
        }
        unsigned sw0 = selm[tokidx * 4 + 0], sw1 = selm[tokidx * 4 + 1], sw2 = selm[tokidx * 4 + 2], sw3 = selm[tokidx * 4 + 3];
#if SEL_SPLIT
        {
            const int cur1 = (32 * uu1) >> 6;
            flash_branch3<BR_SEL, true, 4, false, SEL_PVF>(St, qr, kvc + (size_t)(0 * 2 + g) * S * 128, kvc + (size_t)(1 * 2 + g) * S * 128, (size_t)128, 0, cur1, IDLE_MUL * (cur1 + 1), cur1, lds, al_l, tl, sw0, sw1, sw2, sw3, cur, w, lane);
            const int tl2 = 32 * uu0 + 8 * wq + (r32 >> 2);
            if (half) {
                nsa3_finish<false, false>(St, gate_l[1 * 256 + rowwg] * (St.l > 0.f ? 1.0f / St.l : 0.f), al_l, accw, outw, lane);
                const int tk2 = 8 * wq + (r32 >> 2);
                sw0 = selm[tk2 * 4 + 0]; sw1 = selm[tk2 * 4 + 1]; sw2 = selm[tk2 * 4 + 2]; sw3 = selm[tk2 * 4 + 3];
#pragma unroll
                for (int d0 = 0; d0 < 8; ++d0) qr[d0] = *(const bf16x8*)((const bf16*)(F.ws + WS_QR) + (size_t)tl2 * 1024 + head * 128 + d0 * 16 + hi * 8);
            }
            const int R = cur0 - cur1, y = (R + 1) >> 1;
            const int jf2 = half ? cur1 + 1 + y : cur1 + 1, jl2 = half ? cur0 : cur1 + y;
            flash_branch3<BR_SEL, false, 2, true, SEL_PVF2>(St, qr, kvc + (size_t)(0 * 2 + g) * S * 128, kvc + (size_t)(1 * 2 + g) * S * 128, (size_t)128, jf2, jl2, IDLE_MUL * y, jl2, lds, al_l, tl2, sw0, sw1, sw2, sw3, cur0, w, lane);
            nsa3_merge(St, gate_l[1 * 256 + wq * 32 + r32], lds, al_l, w, lane);
            if (!half) nsa3_finish<false, false>(St, 1.0f, al_l, accw, outw, lane);
            else {
#pragma unroll
                for (int d0 = 0; d0 < 8; ++d0) qr[d0] = *(const bf16x8*)((const bf16*)(F.ws + WS_QR) + (size_t)tl * 1024 + head * 128 + d0 * 16 + hi * 8);
            }
        }
#else
        for (int rep_ = 0; rep_ < REP_SELB; ++rep_)
        flash_branch3<BR_SEL, true, 4>(St, qr, kvc + (size_t)(0 * 2 + g) * S * 128, kvc + (size_t)(1 * 2 + g) * S * 128, (size_t)128, 0, cur, cur0 + 1, cur0, lds, al_l, tl, sw0, sw1, sw2, sw3, cur, w, lane);
        nsa3_finish<false, false>(St, gate_l[1 * 256 + rowwg] * (St.l > 0.f ? 1.0f / St.l : 0.f), al_l, accw, outw, lane);
#endif
        {
            const int jf = (t0 - (WINDOW - 1)) < 0 ? 0 : (t0 - (WINDOW - 1)) >> 6;
            const int t00 = 32 * uu0, t01 = 32 * uu1;
            const int n0 = (t00 >> 6) - ((t00 - (WINDOW - 1)) < 0 ? 0 : (t00 - (WINDOW - 1)) >> 6) + 1, n1 = (t01 >> 6) - ((t01 - (WINDOW - 1)) < 0 ? 0 : (t01 - (WINDOW - 1)) >> 6) + 1;
            for (int rep_ = 0; rep_ < REP_WINB; ++rep_)
            flash_branch3<BR_WIN, false, 2, false, WIN_PVF>(St, qr, kvc + (size_t)(2 * 2 + g) * S * 128, kvc + (size_t)(3 * 2 + g) * S * 128, (size_t)128, jf, cur, n0 > n1 ? n0 : n1, cur, lds, al_l, tl, 0u, 0u, 0u, 0u, cur, w, lane);
            nsa3_finish<false, true>(St, gate_l[2 * 256 + rowwg] * (St.l > 0.f ? 1.0f / St.l : 0.f), al_l, accw, outw, lane);
        }
    }
}

namespace hgm {
typedef short bf16x8 __attribute__((ext_vector_type(8)));
constexpr int HQ = 136, HS = 72;
constexpr int QV_OFF = 0, KV_OFF = 112 * HQ * 2, QC_OFF = KV_OFF + 112 * HQ * 2, ST_OFF = QC_OFF + 64 * HQ * 2, VT_OFF = ST_OFF + 128 * HQ * 2, AL_OFF = VT_OFF + 128 * HS * 2,
              TOT_OFF = AL_OFF + 64 * HS * 2, SSQ_OFF = TOT_OFF + 4 * 128 * 4, KT_OFF = 0;
static_assert(SSQ_OFF + 64 * 2 * 4 <= LDSCTL_OFF, "HGRN LDS map");
struct Prep { float q[16], k[16], v[16], b[16]; float B1, B2, B3, B4; };
struct Raw { bf16 f[16], q[16], v[16]; };
template <bool WITHQ>
__device__ __forceinline__ void load_raw(Frame& F, int c, int h, Raw& R) {
    const int I = F.tid >> 7, d = F.tid & 127;
    const bf16* zr = (const bf16*)(F.ws + WS_Z) + (size_t)(c * HGC + 16 * I) * ZLD + h * 128 + d;
#pragma unroll
    for (int i = 0; i < 16; ++i) { const bf16* zp = zr + (size_t)i * ZLD; R.f[i] = zp[ZFH]; R.q[i] = WITHQ ? zp[ZQH] : (bf16)0; R.v[i] = zp[ZIH]; }
}
__device__ __forceinline__ void prep(Frame& F, int l, int h, const Raw& R, Prep& P, LAS float* tot) {
    const int I = F.tid >> 7, d = F.tid & 127;
    const float lb = ((const float*)(F.ws + WS_LB))[l * 1024 + h * 128 + d];
    float run = 0.f;
#pragma unroll
    for (int i = 0; i < 16; ++i) {
        const float x = fminf(fmaxf(bf2f(R.f[i]), -80.f), 80.f);
        const float sp = __builtin_amdgcn_rcpf(1.0f + __expf(-x)), sn = __builtin_amdgcn_rcpf(1.0f + __expf(x));
        const float lf = __logf(lb + (1.0f - lb) * sp); run += lf; P.b[i] = run; P.k[i] = (1.0f - lb) * sn; P.q[i] = bf2f(R.q[i]); P.v[i] = bf2f(R.v[i]); }
    tot[I * 128 + d] = run;
    __syncthreads();
    P.B1 = tot[d]; P.B2 = P.B1 + tot[128 + d]; P.B3 = P.B2 + tot[256 + d]; P.B4 = P.B3 + tot[384 + d];
    const float BI = I == 0 ? 0.f : (I == 1 ? P.B1 : (I == 2 ? P.B2 : P.B3));
#pragma unroll
    for (int i = 0; i < 16; ++i) P.b[i] += BI;
}
__device__ __forceinline__ bf16 tobf(float x) { return (bf16)f2bf(x); }
}

__device__ __forceinline__ void hgrn_pass1_mfma(Frame& F, int l) {
    using namespace hgm;
    const int lane = F.lane, w = F.wave, fr = lane & 15, fq = lane >> 4;
    LAS bf16* KT = (LAS bf16*)(F.lds + KT_OFF);
    LAS bf16* VT = (LAS bf16*)(F.lds + VT_OFF);
    LAS float* tot = (LAS float*)(F.lds + TOT_OFF);
    float* hgD = (float*)(F.ws + WS_HGD); float* hgS = (float*)(F.ws + WS_HGS);
    Raw Rn; if (F.bid < HGNC * 8) load_raw<false>(F, F.bid >> 3, F.bid & 7, Rn);
    for (int it = F.bid; it < HGNC * 8; it += F.G) {
        const int c = it >> 3, h = it & 7, I = F.tid >> 7, d = F.tid & 127;
        const Raw Rc = Rn;
        if (it + F.G < HGNC * 8) load_raw<false>(F, (it + F.G) >> 3, (it + F.G) & 7, Rn);
        Prep P; prep(F, l, h, Rc, P, tot);
#pragma unroll
        for (int i = 0; i < 16; ++i) { KT[d * HS + 16 * I + i] = tobf(P.k[i] * __expf(P.B4 - P.b[i])); VT[d * HS + 16 * I + i] = tobf(P.v[i]); }
        if (I == 0) hgD[(size_t)it * 128 + d] = __expf(P.B4);
        __syncthreads();
        pg8::f32x4 acc[8];
#pragma unroll
        for (int dt = 0; dt < 8; ++dt) acc[dt] = (pg8::f32x4){0.f, 0.f, 0.f, 0.f};
#pragma unroll
        for (int ks = 0; ks < 2; ++ks) {
            const bf16x8 af = *(const LAS bf16x8*)(VT + (16 * w + fr) * HS + 32 * ks + 8 * fq);
#pragma unroll
            for (int dt = 0; dt < 8; ++dt) { const bf16x8 bfg = *(const LAS bf16x8*)(KT + (16 * dt + fr) * HS + 32 * ks + 8 * fq);
                acc[dt] = __builtin_amdgcn_mfma_f32_16x16x32_bf16(af, bfg, acc[dt], 0, 0, 0); }
        }
        bf16* o = (bf16*)hgS + (size_t)it * 16384 + (size_t)(16 * w + 4 * fq) * 128 + fr;
#pragma unroll
        for (int dt = 0; dt < 8; ++dt)
#pragma unroll
            for (int e = 0; e < 4; ++e) o[e * 128 + 16 * dt] = tobf(acc[dt][e]);
        __syncthreads();
    }
}

__device__ __forceinline__ void hgrn_pass3_mfma(Frame& F, int l) {
    using namespace hgm;
    const int lane = F.lane, w = F.wave, fr = lane & 15, fq = lane >> 4, tid = F.tid;
    LAS bf16* QV = (LAS bf16*)(F.lds + QV_OFF); LAS bf16* KV = (LAS bf16*)(F.lds + KV_OFF); LAS bf16* QC = (LAS bf16*)(F.lds + QC_OFF);
    LAS bf16* ST = (LAS bf16*)(F.lds + ST_OFF); LAS bf16* VT = (LAS bf16*)(F.lds + VT_OFF); LAS bf16* AL = (LAS bf16*)(F.lds + AL_OFF);
    LAS float* tot = (LAS float*)(F.lds + TOT_OFF); LAS float* ssq = (LAS float*)(F.lds + SSQ_OFF);
    const bf16* z = (const bf16*)(F.ws + WS_Z);
    const float* hgS = (const float*)(F.ws + WS_HGS2);
    const float* gn = inp(F, 12) + (size_t)l * 1024;
    bf16* hg = (bf16*)(F.ws + WS_HG);
    Raw Rn; v4u Sn[4];
#if HG_DYN
    unsigned* qh = (unsigned*)(F.ws + WS_CTL) + 1024 + 64 * l;
    LAS unsigned* slot = (LAS unsigned*)(F.lds + LDSCTL_OFF + 64);
    if (tid == 0) *slot = __hip_atomic_fetch_add(qh, 2u, __ATOMIC_RELAXED, __HIP_MEMORY_SCOPE_AGENT);
    __syncthreads();
    int it = (int)*slot, nxt = it + 1;
    __syncthreads();
#define HG_NEXT nxt
#else
    int it = F.bid;
#define HG_NEXT (it + F.G)
#endif
    if (it < HGNC * 8) { load_raw<true>(F, it >> 3, it & 7, Rn);
#pragma unroll
        for (int i = 0; i < 4; ++i) Sn[i] = *(const v4u*)((const bf16*)hgS + (size_t)it * 16384 + (size_t)(tid + 512 * i) * 8); }
    while (it < HGNC * 8) {
        const int c = it >> 3, h = it & 7, I = tid >> 7, d = tid & 127;
#if HG_DYN
        unsigned nq = 0u; if (tid == 0) nq = __hip_atomic_fetch_add(qh, 1u, __ATOMIC_RELAXED, __HIP_MEMORY_SCOPE_AGENT);
#endif
        const Raw Rc = Rn;
#pragma unroll
        for (int i = 0; i < 4; ++i) { const int e8 = tid + 512 * i, v = e8 >> 4, d8 = (e8 & 15) * 8; *(LAS v4u*)(ST + v * HQ + d8) = Sn[i]; }
        if (HG_NEXT < HGNC * 8) { load_raw<true>(F, (HG_NEXT) >> 3, (HG_NEXT) & 7, Rn);
#pragma unroll
            for (int i = 0; i < 4; ++i) Sn[i] = *(const v4u*)((const bf16*)hgS + (size_t)(HG_NEXT) * 16384 + (size_t)(tid + 512 * i) * 8); }
        Prep P; prep(F, l, h, Rc, P, tot);
#pragma unroll
        for (int i = 0; i < 16; ++i) {
            const int row = 16 * I + i; const float b = P.b[i], q = P.q[i], k = P.k[i];
            QC[row * HQ + d] = tobf(q * __expf(b));
            VT[d * HS + row] = tobf(P.v[i]);
            const float BI = I == 0 ? 0.f : (I == 1 ? P.B1 : (I == 2 ? P.B2 : P.B3)), BN = I == 0 ? P.B1 : (I == 1 ? P.B2 : (I == 2 ? P.B3 : P.B4));
            KV[(16 * I + i) * HQ + d] = tobf(k * __expf(fminf(BI - b, 80.f)));
            if (I < 3) KV[(16 * (4 + I) + i) * HQ + d] = tobf(k * __expf(BN - b));
            if (I == 0) QV[i * HQ + d] = tobf(q * __expf(b));
            else if (I == 1) QV[(16 + i) * HQ + d] = tobf(q * __expf(b - P.B1));
            else if (I == 2) { QV[(32 + i) * HQ + d] = tobf(q * __expf(b - P.B1)); QV[(48 + i) * HQ + d] = tobf(q * __expf(b - P.B2)); }
            else { QV[(64 + i) * HQ + d] = tobf(q * __expf(b - P.B1)); QV[(80 + i) * HQ + d] = tobf(q * __expf(b - P.B2)); QV[(96 + i) * HQ + d] = tobf(q * __expf(b - P.B3)); }
        }
        if (tid < 256) { const int blk = tid >> 7, e = tid & 127, r = e >> 3, cc = e & 7;
            const int I0 = blk == 0 ? 0 : 2, J0 = blk == 0 ? 1 : 3; *(LAS unsigned*)(AL + (16 * I0 + r) * HS + 16 * J0 + 2 * cc) = 0u; }
#if HG_DYN
        if (tid == 0) *slot = nq;
#endif
        __syncthreads();
#if HG_DYN
        const int nxt2 = (int)*slot;
#endif
        for (int bi = w; bi < 10; bi += 8) {
            int Ib, Jb;
            if (bi == 0) { Ib = 0; Jb = 0; } else if (bi < 3) { Ib = 1; Jb = bi - 1; } else if (bi < 6) { Ib = 2; Jb = bi - 3; } else { Ib = 3; Jb = bi - 6; }
            const bool diag = Ib == Jb;
            const int rref = diag ? Ib : Jb + 1;
            const int qblk = Ib == 0 ? 0 : (Ib == 1 ? 1 : (Ib == 2 ? 1 + rref : 3 + rref));
            const int kblk = diag ? Jb : 4 + Jb;
            pg8::f32x4 a = {0.f, 0.f, 0.f, 0.f};
#pragma unroll
            for (int ks = 0; ks < 4; ++ks) {
                const bf16x8 af = *(const LAS bf16x8*)(QV + (16 * qblk + fr) * HQ + 32 * ks + 8 * fq);
                const bf16x8 bfg = *(const LAS bf16x8*)(KV + (16 * kblk + fr) * HQ + 32 * ks + 8 * fq);
                a = __builtin_amdgcn_mfma_f32_16x16x32_bf16(af, bfg, a, 0, 0, 0);
            }
#pragma unroll
            for (int e = 0; e < 4; ++e) { const int tl_ = 4 * fq + e; const float val = (diag && fr > tl_) ? 0.f : a[e]; AL[(16 * Ib + tl_) * HS + 16 * Jb + fr] = tobf(val); }
        }
        __syncthreads();
        const int Iw = w >> 1, vh = w & 1;
        bf16 ogr[4][4];
#pragma unroll
        for (int e = 0; e < 4; ++e)
#pragma unroll
            for (int j = 0; j < 4; ++j) ogr[e][j] = z[(size_t)(c * HGC + 16 * Iw + 4 * fq + e) * ZLD + ZOG + h * 128 + 16 * (4 * vh + j) + fr];
        pg8::f32x4 o[4];
#pragma unroll
        for (int j = 0; j < 4; ++j) o[j] = (pg8::f32x4){0.f, 0.f, 0.f, 0.f};
        const int nks = Iw < 2 ? 1 : 2;
        for (int ks = 0; ks < nks; ++ks) {
            const bf16x8 af = *(const LAS bf16x8*)(AL + (16 * Iw + fr) * HS + 32 * ks + 8 * fq);
#pragma unroll
            for (int j = 0; j < 4; ++j) { const bf16x8 bfg = *(const LAS bf16x8*)(VT + (16 * (4 * vh + j) + fr) * HS + 32 * ks + 8 * fq);
                o[j] = __builtin_amdgcn_mfma_f32_16x16x32_bf16(af, bfg, o[j], 0, 0, 0); }
        }
#pragma unroll
        for (int ks = 0; ks < 4; ++ks) {
            const bf16x8 af = *(const LAS bf16x8*)(QC + (16 * Iw + fr) * HQ + 32 * ks + 8 * fq);
#pragma unroll
            for (int j = 0; j < 4; ++j) { const bf16x8 bfg = *(const LAS bf16x8*)(ST + (16 * (4 * vh + j) + fr) * HQ + 32 * ks + 8 * fq);
                o[j] = __builtin_amdgcn_mfma_f32_16x16x32_bf16(af, bfg, o[j], 0, 0, 0); }
        }
#pragma unroll
        for (int e = 0; e < 4; ++e) { float sq = 0.f;
#pragma unroll
            for (int j = 0; j < 4; ++j) sq += o[j][e] * o[j][e];
            sq += __shfl_xor(sq, 1); sq += __shfl_xor(sq, 2); sq += __shfl_xor(sq, 4); sq += __shfl_xor(sq, 8);
            if (fr == 0) ssq[(16 * Iw + 4 * fq + e) * 2 + vh] = sq; }
        __syncthreads();
#pragma unroll
        for (int e = 0; e < 4; ++e) {
            const int row = 16 * Iw + 4 * fq + e, tok = c * HGC + row;
            const float rr = 1.0f / sqrtf((ssq[row * 2] + ssq[row * 2 + 1]) * (1.0f / 128.0f) + EPS);
#pragma unroll
            for (int j = 0; j < 4; ++j) { const int vcol = h * 128 + 16 * (4 * vh + j) + fr;
                const float og = bf2f(ogr[e][j]);
                hg[(size_t)tok * 1024 + vcol] = tobf(o[j][e] * rr * gn[vcol] * siluf_(og)); }
        }
        __syncthreads();
#if HG_DYN
        it = nxt; nxt = nxt2;
#else
        it += F.G;
#endif
    }
#undef HG_NEXT
}

using pg8::Unit; using pg8::f32x4;
struct EpiGateF32 {
    static constexpr bool PERM = true, AFTER_DRAIN = false;
    bf16* C; int ldc; const bf16* G; int ldg;
    __device__ __forceinline__ void operator()(const pg8::f32x4 (&acc)[2][2][4][2], const Unit& u, int wr, int wc, int fr, int fq) const {
        const int row0 = u.pm * 256 + wr * 64 + fr, col0 = u.pn * 256 + wc * 32 + 8 * fq;
#pragma unroll
        for (int ai = 0; ai < 2; ++ai)
#pragma unroll
            for (int m = 0; m < 4; ++m) { const size_t row = (size_t)(row0 + ai * 128 + m * 16);
#pragma unroll
                for (int bj = 0; bj < 2; ++bj) { const int col = col0 + bj * 128;
                    const v4u gw = *(const v4u*)(G + row * ldg + col);
                    const pg8::f32x4 g0 = {sigmoidf_(bflo(gw.x)), sigmoidf_(bfhi(gw.x)), sigmoidf_(bflo(gw.y)), sigmoidf_(bfhi(gw.y))};
                    const pg8::f32x4 g1 = {sigmoidf_(bflo(gw.z)), sigmoidf_(bfhi(gw.z)), sigmoidf_(bflo(gw.w)), sigmoidf_(bfhi(gw.w))};
                    const pg8::f32x4 v0 = acc[ai][bj][m][0] * g0, v1 = acc[ai][bj][m][1] * g1;
                    v4u w; w.x = pk2(v0[0], v0[1]); w.y = pk2(v0[2], v0[3]); w.z = pk2(v1[0], v1[1]); w.w = pk2(v1[2], v1[3]);
                    *(v4u*)(C + row * ldc + col) = w; } }
    }
};
struct EpiMixBf16 {
    static constexpr bool PERM = true, AFTER_DRAIN = false;
    bf16* O; int ldc; const bf16* P; const bf16* G; int ldg;
    __device__ __forceinline__ void operator()(const pg8::f32x4 (&acc)[2][2][4][2], const Unit& u, int wr, int wc, int fr, int fq) const {
        const int row0 = u.pm * 256 + wr * 64 + fr, col0 = u.pn * 256 + wc * 32 + 8 * fq;
#pragma unroll
        for (int ai = 0; ai < 2; ++ai)
#pragma unroll
            for (int m = 0; m < 4; ++m) { const size_t row = (size_t)(row0 + ai * 128 + m * 16);
#pragma unroll
                for (int bj = 0; bj < 2; ++bj) { const int col = col0 + bj * 128;
                    const v4u gw = *(const v4u*)(G + row * ldg + col);
                    const v4u pw = *(const v4u*)(P + row * ldc + col);
                    const pg8::f32x4 p0 = {bflo(pw.x), bfhi(pw.x), bflo(pw.y), bfhi(pw.y)}, p1 = {bflo(pw.z), bfhi(pw.z), bflo(pw.w), bfhi(pw.w)};
                    const pg8::f32x4 g0 = {sigmoidf_(bflo(gw.x)), sigmoidf_(bfhi(gw.x)), sigmoidf_(bflo(gw.y)), sigmoidf_(bfhi(gw.y))};
                    const pg8::f32x4 g1 = {sigmoidf_(bflo(gw.z)), sigmoidf_(bfhi(gw.z)), sigmoidf_(bflo(gw.w)), sigmoidf_(bfhi(gw.w))};
                    const pg8::f32x4 v0 = p0 + acc[ai][bj][m][0] * g0, v1 = p1 + acc[ai][bj][m][1] * g1;
                    v4u w; w.x = pk2(v0[0], v0[1]); w.y = pk2(v0[2], v0[3]); w.z = pk2(v1[0], v1[1]); w.w = pk2(v1[2], v1[3]);
                    *(v4u*)(O + row * ldc + col) = w; } }
    }
};


struct DualOrder {
    int c;
    __device__ __forceinline__ bool next(int i, Unit& u) const {
        if (i >= 2) return false;
        int wgid = c; { const int nwg = 256, q = nwg / 8, xcd = wgid % 8, off = wgid / 8; wgid = xcd * q + off; }
        const int nN = 8, nig = 8 * nN, gid = wgid / nig, fm = gid * 8;
        u.pm = fm + ((wgid % nig) % 8) + 32 * i; u.pn = (wgid % nig) / 8 + 8 * i; return true;
    }
    __device__ __forceinline__ void a_ready(const Unit&) const {}
    __device__ __forceinline__ void done(const Unit&) const {}
};
struct EpiBranch {
    static constexpr bool PERM = true, AFTER_DRAIN = false;
    EpiGateF32 e1; EpiMixBf16 e2;
    __device__ __forceinline__ void operator()(const pg8::f32x4 (&acc)[2][2][4][2], const Unit& u, int wr, int wc, int fr, int fq) const {
        if (u.pm < 32) e1(acc, u, wr, wc, fr, fq);
        else { const Unit v{u.pm - 32, u.pn - 8}; e2(acc, v, wr, wc, fr, fq); }
    }
};

struct EpiBranchCarry {
    static constexpr bool PERM = true, AFTER_DRAIN = false, KEEP_ACC = true;
    bf16* O; int ldc; const bf16* G; int ldg;
    __device__ __forceinline__ bool keep(const Unit& u) const { return u.pm < 32; }
    __device__ __forceinline__ void operator()(pg8::f32x4 (&acc)[2][2][4][2], const Unit& u, int wr, int wc, int fr, int fq) const {
        const bool first = u.pm < 32;
        const int pm = first ? u.pm : u.pm - 32, pn = first ? u.pn : u.pn - 8;
        const int row0 = pm * 256 + wr * 64 + fr, col0 = pn * 256 + wc * 32 + 8 * fq;
#pragma unroll
        for (int ai = 0; ai < 2; ++ai)
#pragma unroll
            for (int m = 0; m < 4; ++m) { const size_t row = (size_t)(row0 + ai * 128 + m * 16);
#pragma unroll
                for (int bj = 0; bj < 2; ++bj) { const int col = col0 + bj * 128;
                    const v4u hw = *(const v4u*)(G + row * ldg + D + col);
                    float eh[8] = {bflo(hw.x), bfhi(hw.x), bflo(hw.y), bfhi(hw.y), bflo(hw.z), bfhi(hw.z), bflo(hw.w), bfhi(hw.w)};
#pragma unroll
                    for (int e = 0; e < 8; ++e) eh[e] = 1.0f + __expf(-fmaxf(eh[e], -40.0f));
                    if (first) {
                        const v4u gw = *(const v4u*)(G + row * ldg + col);
                        const float ga[8] = {bflo(gw.x), bfhi(gw.x), bflo(gw.y), bfhi(gw.y), bflo(gw.z), bfhi(gw.z), bflo(gw.w), bfhi(gw.w)};
#pragma unroll
                        for (int e = 0; e < 8; ++e) acc[ai][bj][m][e >> 2][e & 3] *= eh[e] * sigmoidf_(ga[e]);
                    } else {
                        float v[8];
#pragma unroll
                        for (int e = 0; e < 8; ++e) v[e] = acc[ai][bj][m][e >> 2][e & 3] * __builtin_amdgcn_rcpf(eh[e]);
                        v4u w; w.x = pk2(v[0], v[1]); w.y = pk2(v[2], v[3]); w.z = pk2(v[4], v[5]); w.w = pk2(v[6], v[7]);
                        *(v4u*)(O + row * ldc + col) = w;
                    } } }
    }
};

template <int N> __device__ __forceinline__ float ror16(float x) {
    return __int_as_float(__builtin_amdgcn_update_dpp(0, __float_as_int(x), 0x120 + N, 0xf, 0xf, false));
}
struct EpiConvGate {
    static constexpr bool PERM = true, AFTER_DRAIN = false;
    bf16* O; const float* cw; const float* cb;
    __device__ __forceinline__ void operator()(const pg8::f32x4 (&acc)[2][2][4][2], const Unit& u, int wr, int wc, int fr, int fq) const {
        const int cbase = u.pn * 128 + wc * 32 + 8 * fq;
#pragma unroll
        for (int n = 0; n < 2; ++n) {
            const int c0 = cbase + 4 * n;
            const pg8::f32x4 bg = *(const pg8::f32x4*)(cb + c0), bv = *(const pg8::f32x4*)(cb + DFF + c0);
            const pg8::f32x4 g0 = *(const pg8::f32x4*)(cw + c0), g1 = *(const pg8::f32x4*)(cw + NUP + c0), g2 = *(const pg8::f32x4*)(cw + 2 * NUP + c0);
            const pg8::f32x4 v0 = *(const pg8::f32x4*)(cw + DFF + c0), v1 = *(const pg8::f32x4*)(cw + NUP + DFF + c0), v2 = *(const pg8::f32x4*)(cw + 2 * NUP + DFF + c0);
#pragma unroll
            for (int ai = 0; ai < 2; ++ai) {
                const int tok0 = u.pm * 248 + 62 * (2 * ai + wr) - 2 + fr;
#pragma unroll
                for (int m = 0; m < 4; ++m) {
                    pg8::f32x4 og, ov;
#pragma unroll
                    for (int x = 0; x < 4; ++x) {
                        const float ug = acc[ai][0][m][n][x], uv = acc[ai][1][m][n][x];
                        const float pg_ = m > 0 ? acc[ai][0][m > 0 ? m - 1 : 0][n][x] : 0.f, pv_ = m > 0 ? acc[ai][1][m > 0 ? m - 1 : 0][n][x] : 0.f;
                        const float g1s = ror16<1>(fr == 15 ? pg_ : ug), g2s = ror16<2>(fr >= 14 ? pg_ : ug);
                        const float v1s = ror16<1>(fr == 15 ? pv_ : uv), v2s = ror16<2>(fr >= 14 ? pv_ : uv);
                        og[x] = bg[x] + g0[x] * g2s + g1[x] * g1s + g2[x] * ug;
                        ov[x] = bv[x] + v0[x] * v2s + v1[x] * v1s + v2[x] * uv;
                    }
                    const int tok = tok0 + 16 * m;
                    if ((m > 0 || fr >= 2) && tok < S) {
                        v2u w; w.x = pk2(siluf_(og[0]) * ov[0], siluf_(og[1]) * ov[1]); w.y = pk2(siluf_(og[2]) * ov[2], siluf_(og[3]) * ov[3]);
                        *(v2u*)(O + (size_t)tok * DFF + c0) = w;
                    }
                }
            }
        }
    }
};

__device__ __forceinline__ void make_frame(Frame& F, const Args& args, unsigned char* lds_raw) {
    F.lds = (LAS unsigned char*)lds_raw;
    F.tid = threadIdx.x; F.lane = F.tid & 63; F.wave = __builtin_amdgcn_readfirstlane(F.tid >> 6);
    F.G = gridDim.x; F.bid = blockIdx.x; F.ws = args.ws; F.out = args.out;
    for (int u = F.tid; u < (LDS_BYTES - LDSCTL_OFF) / 4; u += 512) ((LAS unsigned*)(F.lds + LDSCTL_OFF))[u] = 0u;
    __syncthreads();
    if (F.tid == 0) {
#pragma unroll
        for (int i = 0; i < 23; ++i) ((LAS unsigned long long*)(F.lds + LDSCTL_OFF + 128))[i] = (unsigned long long)args.in[i];
    }
    __syncthreads();
}
__device__ __forceinline__ void relaunder(Frame& F, const Args& args) {
    int t = threadIdx.x; asm volatile("" : "+v"(t)); F.tid = t; F.lane = t & 63; F.wave = __builtin_amdgcn_readfirstlane(t >> 6);
    int b = blockIdx.x; asm volatile("" : "+s"(b)); F.bid = b;
    unsigned char* w = args.ws; asm volatile("" : "+s"(w)); F.ws = w;
    float* o = args.out; asm volatile("" : "+s"(o)); F.out = o;
}
#ifndef REP_NSA
#define REP_NSA 1
#endif
#ifndef REP_HG
#define REP_HG 1
#endif
#ifndef REP_GEMM
#define REP_GEMM 1
#endif
constexpr int PH_PER_LAYER = 10, PH_FIRST = 3, N_PHASES = PH_FIRST + NL * PH_PER_LAYER;

__global__ void __launch_bounds__(512, 2) fwd(Args args) {
    extern __shared__ __attribute__((aligned(16))) unsigned char lds_raw[];
    Frame F; make_frame(F, args, lds_raw);
    const int lo = args.ph_lo, hi = args.ph_hi;
    unsigned* barw = (unsigned*)(F.ws + WS_CTL) + CW_BAR;
    XcdBarrier bar; bar.bar = barw; bar.x = 0; bar.st = nullptr;
    if (hi - lo > 1) bar = xcd_barrier_post(barw, (volatile LAS unsigned*)(F.lds + LDSCTL_OFF));
#define GEMMX(EPI, AOVL_) do { if (GEMM_V2) pg8::gemm_phase2<EPI, pg8::StaticOrder, G2_ALIGN, G2_SP2, AOVL_>(F.lds, g, So, E); else pg8::gemm_phase<EPI, pg8::StaticOrder, false, AOVL_>(F.lds, g, So, E, nullptr); } while (0)
#define IN(k) (lo <= (k) && (k) < hi)
#define PH(k) if (IN(k) && (relaunder(F, args), true))
#define SEAM(k) do { if (IN(k) && IN((k) + 1)) { for (int rb_ = 0; rb_ < REP_BAR; ++rb_) xcd_barrier(bar); } } while (0)

#define ada ((const float*)(F.ws + WS_ADA))
#define hbuf ((bf16*)(F.ws + WS_H2) + 2 * D)
#define resb ((bf16*)(F.ws + WS_H))
#define zbuf ((bf16*)(F.ws + WS_Z))
#define ybuf ((bf16*)(F.ws + WS_Y))
#define part ((bf16*)(F.ws + WS_PART + 32 * MiB))
#define mixed ((bf16*)(F.ws + WS_MIXED))
#define gbuf ((bf16*)(F.ws + WS_G))
#define attn ((bf16*)(F.ws + WS_ATTN))
#define hgb ((bf16*)(F.ws + WS_HG))

    PH(0) { for (int rep = 0; rep < REP_P0; ++rep) { p0_prologue(F); __syncthreads(); } } SEAM(0);
    PH(1) { p0b_ada(F); } SEAM(1);
    PH(2) { row_phase<false, true>(F, inp(F, 0), nullptr, nullptr, hbuf, nullptr, nullptr, inp(F, 5), ada + 1 * D, ada + 0 * D); } SEAM(2);

    for (int l = 0; l < NL; ++l) {
        const int pb = PH_FIRST + l * PH_PER_LAYER;
#define adal (ada + (size_t)l * NADA)
        PH(pb + 0) {
            const int ngz = (CONV_AHEAD && l + 1 < NL && F.G == 256) ? NGZ : F.G;
            pg8::Gemm g{hbuf, (const bf16*)(F.ws + WS_WIN) + (size_t)l * ZLD * D, S, ZLD, D}; pg8::StaticOrder So; So.init(S, ZLD, ngz, F.bid);
            pg8::EpiBf16<0> E{zbuf, ZLD, nullptr, 0, 0};
            if (F.bid < ngz) for (int rep = 0; rep < REP_GEMM * REP_GZ; ++rep) { GEMMX(pg8::EpiBf16<0>, false); __syncthreads(); }
            if (CONV_AHEAD && l + 1 < NL) convert_queue(F, l + 1);
        } SEAM(pb + 0);
        PH(pb + 1) { phase_c(F, l); __syncthreads(); for (int rep = 0; rep < REP_P1; ++rep) hgrn_pass1_mfma(F, l); } SEAM(pb + 1);
        PH(pb + 2) { for (int rep = 0; rep < REP_P2; ++rep) hgrn_pass2(F); __syncthreads(); for (int rep = 0; rep < REP_CMPR; ++rep) compress_mfma(F, l); } SEAM(pb + 2);
        PH(pb + 3) { for (int rep = 0; rep < REP_NSA; ++rep) { nsa3_phase(F, l); __syncthreads(); }
                     for (int rep = 0; rep < REP_HG; ++rep) { hgrn_pass3_mfma(F, l); __syncthreads(); } } SEAM(pb + 3);
        PH(pb + 4) {
            if (F.G == 256) {
                pg8::Gemm g{attn, (const bf16*)(F.ws + WS_WBA) + (size_t)l * 2 * D * 1024, 2 * S, 2 * D, 1024}; DualOrder So; So.c = F.bid;
#if BR_CARRY
                EpiBranchCarry E{mixed, D, zbuf + ZMG, ZLD};
                for (int rep = 0; rep < REP_GEMM * REP_GF; ++rep) { pg8::gemm_phase2<EpiBranchCarry, DualOrder, G2_ALIGN, G2_SP2, false>(F.lds, g, So, E); __syncthreads(); }
#else
                EpiBranch E{EpiGateF32{part, D, zbuf + ZMG, ZLD}, EpiMixBf16{mixed, D, part, zbuf + ZMG + D, ZLD}};
                for (int rep = 0; rep < REP_GEMM * REP_GF; ++rep) { if (GEMM_V2) pg8::gemm_phase2<EpiBranch, DualOrder, G2_ALIGN, G2_SP2, false>(F.lds, g, So, E); else pg8::gemm_phase<EpiBranch, DualOrder, false, false>(F.lds, g, So, E, nullptr); __syncthreads(); }
#endif
            } else {
                { pg8::Gemm g{attn, (const bf16*)(F.ws + WS_WBA) + (size_t)l * 2 * D * 1024, S, D, 1024}; pg8::StaticOrder So; So.init(S, D, F.G, F.bid);
                  EpiGateF32 E{part, D, zbuf + ZMG, ZLD}; GEMMX(EpiGateF32, false); }
                xcd_barrier(bar);
                { pg8::Gemm g{hgb, (const bf16*)(F.ws + WS_WBA) + (size_t)(l * 2 + 1) * D * 1024, S, D, 1024}; pg8::StaticOrder So; So.init(S, D, F.G, F.bid);
                  EpiMixBf16 E{mixed, D, part, zbuf + ZMG + D, ZLD}; GEMMX(EpiMixBf16, false); }
            }
        } SEAM(pb + 4);
        PH(pb + 5) {
            pg8::Gemm g{mixed, (const bf16*)(F.ws + WS_WOUT) + (size_t)l * D * D, S, D, D}; pg8::StaticOrder So; So.init(S, D, F.G, F.bid);
            pg8::EpiBf16<0> E{ybuf, D, nullptr, 0, 0};
            for (int rep = 0; rep < REP_GEMM * REP_GG; ++rep) { GEMMX(pg8::EpiBf16<0>, false); __syncthreads(); }
        } SEAM(pb + 5);
        PH(pb + 6) {
#if RES_BF16
            if (l == 0) row_phase<true, true, false, true>(F, inp(F, 0), ybuf, resb, hbuf, inp(F, 16) + (size_t)l * D, adal + 2 * D, inp(F, 17) + (size_t)l * D, adal + 4 * D, adal + 3 * D);
            else row_phase<true, true, true, true>(F, resb, ybuf, resb, hbuf, inp(F, 16) + (size_t)l * D, adal + 2 * D, inp(F, 17) + (size_t)l * D, adal + 4 * D, adal + 3 * D);
#else
            row_phase<true, true>(F, l == 0 ? inp(F, 0) : F.out, ybuf, F.out, hbuf, inp(F, 16) + (size_t)l * D, adal + 2 * D, inp(F, 17) + (size_t)l * D, adal + 4 * D, adal + 3 * D);
            for (int rep = 0; rep < REP_ROWPRE; ++rep) { __syncthreads(); row_phase<false, true>(F, F.out, nullptr, nullptr, hbuf, nullptr, nullptr, inp(F, 17) + (size_t)l * D, adal + 4 * D, adal + 3 * D); }
#endif
        } SEAM(pb + 6);
        PH(pb + 7) {
            pg8::Gemm g{(const bf16*)(F.ws + WS_H2), (const bf16*)(F.ws + WS_WUP) + (size_t)l * NUP * D, 34 * 256, NUP, D}; pg8::StaticOrder So; So.init(34 * 256, NUP, F.G, F.bid);
            EpiConvGate E{gbuf, inp(F, 19) + (size_t)l * 3 * NUP, inp(F, 20) + (size_t)l * NUP};
            for (int rep = 0; rep < REP_GEMM * REP_GU; ++rep) { GEMMX(EpiConvGate, true); __syncthreads(); }
        } SEAM(pb + 7);
        PH(pb + 8) {
            pg8::Gemm g{gbuf, (const bf16*)(F.ws + WS_WDN) + (size_t)l * D * DFF, S, D, DFF}; pg8::StaticOrder So; So.init(S, D, F.G, F.bid);
            pg8::EpiBf16<0> E{ybuf, D, nullptr, 0, 0};
            for (int rep = 0; rep < REP_GEMM * REP_GD; ++rep) { GEMMX(pg8::EpiBf16<0>, false); __syncthreads(); }
        } SEAM(pb + 8);
        PH(pb + 9) {
#if RES_BF16
            if (l + 1 < NL) row_phase<true, true, true, true>(F, resb, ybuf, resb, hbuf, inp(F, 22) + (size_t)l * D, adal + 5 * D, inp(F, 5) + (size_t)(l + 1) * D, adal + NADA + 1 * D, adal + NADA + 0 * D);
            else row_phase<true, false, true, false>(F, resb, ybuf, F.out, hbuf, inp(F, 22) + (size_t)l * D, adal + 5 * D, nullptr, nullptr, nullptr);
#else
            if (l + 1 < NL) row_phase<true, true>(F, F.out, ybuf, F.out, hbuf, inp(F, 22) + (size_t)l * D, adal + 5 * D, inp(F, 5) + (size_t)(l + 1) * D, adal + NADA + 1 * D, adal + NADA + 0 * D);
            else row_phase<true, false>(F, F.out, ybuf, F.out, hbuf, inp(F, 22) + (size_t)l * D, adal + 5 * D, nullptr, nullptr, nullptr);
#endif
        }
        if (l + 1 < NL) SEAM(pb + 9);
    }
#undef IN
#undef PH
#undef ada
#undef hbuf
#undef zbuf
#undef ybuf
#undef part
#undef mixed
#undef gbuf
#undef attn
#undef hgb
#undef adal
#undef SEAM
}
}

#ifndef MK_SINGLE
#define MK_SINGLE 0
#endif
extern "C" void kernel_launch(void* const* d_in, const int* in_sizes, int n_in, void* d_out, int out_size, void* d_ws, size_t ws_size, hipStream_t stream) {
    using namespace mk;
    static int grid = 0;
    if (grid == 0) {
        if (n_in != 23 || out_size != S * D || ws_size < WS_END) { fprintf(stderr, "kernel_launch: unexpected shapes (n_in %d out %d ws %zu)\n", n_in, out_size, ws_size); grid = -1; return; }
        int dev = 0, cus = 0, per_cu = 0;
        if (hipGetDevice(&dev) != hipSuccess || hipDeviceGetAttribute(&cus, hipDeviceAttributeMultiprocessorCount, dev) != hipSuccess) { grid = -1; return; }
        if (hipFuncSetAttribute((const void*)fwd, hipFuncAttributeMaxDynamicSharedMemorySize, LDS_BYTES) != hipSuccess) { fprintf(stderr, "kernel_launch: hipFuncSetAttribute failed\n"); grid = -1; return; }
        if (hipOccupancyMaxActiveBlocksPerMultiprocessor(&per_cu, (const void*)fwd, 512, LDS_BYTES) != hipSuccess || per_cu < 1) fprintf(stderr, "kernel_launch: occupancy query says %d\n", per_cu);
        (void)hipGetLastError();
        grid = cus;
    }
    if (grid < 0) return;
    (void)hipMemsetAsync((char*)d_ws + WS_CTL, 0, CTL_ZERO_BYTES, stream);
    Args a{};
    for (int i = 0; i < 23; ++i) a.in[i] = (const float*)d_in[i];
    a.out = (float*)d_out; a.ws = (unsigned char*)d_ws;
#if MK_SINGLE
    a.ph_lo = 0; a.ph_hi = N_PHASES;
    hipLaunchKernelGGL(fwd, dim3(grid), dim3(512), LDS_BYTES, stream, a);
#else
    for (int p = 0; p < N_PHASES; ++p) { a.ph_lo = p; a.ph_hi = p + 1; hipLaunchKernelGGL(fwd, dim3(grid), dim3(512), LDS_BYTES, stream, a); }
#endif
}
```

```cpp
#include <hip/hip_runtime.h>
#include <cstdio>
#include <cstdint>
#define MK_SINGLE 1
namespace pg8 {
#define PG8_LAS __attribute__((address_space(3)))
typedef unsigned short bf16_t;
typedef short bf16x8 __attribute__((ext_vector_type(8)));
typedef float f32x4 __attribute__((ext_vector_type(4)));
typedef unsigned u32x4 __attribute__((ext_vector_type(4)));
constexpr int BM = 256, BK = 64, HALF = 128, HTB = HALF * BK * 2  , STAGE_BYTES = 8 * HTB, NXCD = 8, WGM = 8;

__host__ __device__ __forceinline__ int lds_byte(int r, int c) { const int st = (r >> 4) * 2 + (c >> 5), rr = r & 15, cc = c & 31, ob = rr * 64 + cc * 2; return st * 1024 + (ob ^ (((ob >> 9) & 1) << 5)); }
__host__ __device__ __forceinline__ void stage_rc(int b, int& R, int& C) { const int st = b / 1024, sb = b % 1024, swz = sb ^ (((sb >> 9) & 1) << 5); R = (st >> 1) * 16 + swz / 64; C = (st & 1) * 32 + (swz % 64) / 2; }
__host__ __device__ __forceinline__ int perm32(int rho) { const int n = rho >> 4, i = rho & 15; return 8 * (i >> 2) + 4 * n + (i & 3); }

struct Unit { int pm, pn; };
struct Gemm { const bf16_t* A; const bf16_t* Bt; int M, N, K; };

struct StaticOrder {
    int nM, nN, nwg, G, c;
    __host__ __device__ void init(int M, int N, int G_, int c_) { nM = M / BM; nN = N / BM; nwg = nM * nN; G = G_; c = c_; }
    __host__ __device__ bool next(int i, Unit& u) const {
        const long L = (long)i * G + c; if (L >= nwg) return false;
        int wgid = (int)L; { const int q = nwg / NXCD, r = nwg % NXCD, xcd = wgid % NXCD, off = wgid / NXCD; wgid = (xcd < r ? xcd * (q + 1) : r * (q + 1) + (xcd - r) * q) + off; }
        const int nig = WGM * nN, gid = wgid / nig, fm = gid * WGM, gsz = (nM - fm) < WGM ? (nM - fm) : WGM;
        u.pm = fm + ((wgid % nig) % gsz); u.pn = (wgid % nig) / gsz; return true;
    }
    __device__ __forceinline__ void a_ready(const Unit&) const {}
    __device__ __forceinline__ void done(const Unit&) const {}
};
struct CountedOrder : StaticOrder {
    const unsigned* ready; unsigned need; unsigned* tmo;
    __device__ __forceinline__ void a_ready(const Unit& u) const {
        if (threadIdx.x < 64) {
            const unsigned long long t0 = __builtin_amdgcn_s_memrealtime(); unsigned polls = 0;
            while ((unsigned)__builtin_amdgcn_readfirstlane(__hip_atomic_load(ready + 64 * u.pm, __ATOMIC_RELAXED, __HIP_MEMORY_SCOPE_AGENT)) < need) {
                if ((++polls & 255u) == 0u && __builtin_amdgcn_readfirstlane(__hip_atomic_load(tmo, __ATOMIC_RELAXED, __HIP_MEMORY_SCOPE_AGENT)) != 0u) break;
                if (__builtin_amdgcn_s_memrealtime() - t0 > 2000000ull) {
                    if (threadIdx.x == 0) { unsigned expect = 0u; __hip_atomic_compare_exchange_strong(tmo + 1, &expect, 0x600u | (unsigned)(u.pm & 0xff), __ATOMIC_RELAXED, __ATOMIC_RELAXED, __HIP_MEMORY_SCOPE_AGENT); __hip_atomic_store(tmo, 1u, __ATOMIC_RELAXED, __HIP_MEMORY_SCOPE_AGENT); }
                    break; }
                __builtin_amdgcn_s_sleep(2); }
            __builtin_amdgcn_fence(__ATOMIC_ACQUIRE, "agent");
            asm volatile("s_waitcnt vmcnt(0)" ::: "memory");
        }
#if !defined(BROKEN_HOOK_NO_BARRIER)
        asm volatile("" ::: "memory"); __builtin_amdgcn_s_barrier(); asm volatile("" ::: "memory");
#endif
    }
};

typedef __bf16 bf16x2n_t __attribute__((ext_vector_type(2))); typedef float f32x2n_t __attribute__((ext_vector_type(2)));
__device__ __forceinline__ unsigned cvt_pk_bf16(float lo, float hi) { const f32x2n_t v = {lo, hi}; return __builtin_bit_cast(unsigned, __builtin_convertvector(v, bf16x2n_t)); }
typedef float f32x2 __attribute__((ext_vector_type(2)));
__device__ __forceinline__ f32x2 gelu_pk(f32x2 v) {
    const f32x2 av = __builtin_elementwise_abs(v), d = av * 0.2316418882f + 1.0f;
    f32x2 t; t.x = __builtin_amdgcn_rcpf(d.x); t.y = __builtin_amdgcn_rcpf(d.y);
    f32x2 q = t * 0.5307027145f + (-0.7265760135f); q = q * t + 0.7107068705f; q = q * t + (-0.142248368f); q = q * t + 0.127414796f; q = q * t;
    const f32x2 s = (v * v) * (-0.72134752044f);
    f32x2 e; e.x = __builtin_amdgcn_exp2f(s.x); e.y = __builtin_amdgcn_exp2f(s.y);
    const f32x2 m = v * (q * e), r = v - m;
    f32x2 o; o.x = v.x < 0.f ? m.x : r.x; o.y = v.y < 0.f ? m.y : r.y; return o;
}

struct EpiF32 {
    static constexpr bool PERM = false, AFTER_DRAIN = false;
    float* C; int ldc; const float* bias;
    __device__ __forceinline__ void operator()(const f32x4 (&acc)[2][2][4][2], const Unit& u, int wr, int wc, int fr, int fq) const {
        const int row0 = u.pm * BM + wr * 64 + fr, col0 = u.pn * BM + wc * 32 + 4 * fq;
        f32x4 bv[2][2];
#pragma unroll
        for (int bj = 0; bj < 2; ++bj)
#pragma unroll
            for (int n = 0; n < 2; ++n) bv[bj][n] = bias ? *(const f32x4*)(bias + col0 + bj * HALF + n * 16) : (f32x4){0.f, 0.f, 0.f, 0.f};
#pragma unroll
        for (int ai = 0; ai < 2; ++ai)
#pragma unroll
            for (int m = 0; m < 4; ++m) { float* rowp = C + (size_t)(row0 + ai * HALF + m * 16) * ldc + col0;
#pragma unroll
                for (int bj = 0; bj < 2; ++bj)
#pragma unroll
                    for (int n = 0; n < 2; ++n) *(f32x4*)(rowp + bj * HALF + n * 16) = acc[ai][bj][m][n] + bv[bj][n]; }
    }
};
template <int ACT  > struct EpiBf16 {
    static constexpr bool PERM = true, AFTER_DRAIN = false;
    bf16_t* O; int ldc; const float* bias; int split_cols; size_t split_stride;
    __device__ __forceinline__ void operator()(const f32x4 (&acc)[2][2][4][2], const Unit& u, int wr, int wc, int fr, int fq) const {
        const int row0 = u.pm * BM + wr * 64 + fr; int colt = u.pn * BM; bf16_t* base = O;
        if (split_cols) { const int t = colt / split_cols; base += (size_t)t * split_stride; colt -= t * split_cols; }
        const int col0 = colt + wc * 32 + 8 * fq, bcol0 = u.pn * BM + wc * 32 + 8 * fq;
        f32x4 bv[2][2];
#pragma unroll
        for (int bj = 0; bj < 2; ++bj)
#pragma unroll
            for (int n = 0; n < 2; ++n) bv[bj][n] = bias ? *(const f32x4*)(bias + bcol0 + bj * HALF + 4 * n) : (f32x4){0.f, 0.f, 0.f, 0.f};
#pragma unroll
        for (int ai = 0; ai < 2; ++ai)
#pragma unroll
            for (int m = 0; m < 4; ++m) { bf16_t* rowp = base + (size_t)(row0 + ai * HALF + m * 16) * ldc + col0;
#pragma unroll
                for (int bj = 0; bj < 2; ++bj) { f32x4 v0 = acc[ai][bj][m][0] + bv[bj][0], v1 = acc[ai][bj][m][1] + bv[bj][1];
                    if (ACT == 1) { f32x2 a = gelu_pk((f32x2){v0[0], v0[1]}), b = gelu_pk((f32x2){v0[2], v0[3]}), c = gelu_pk((f32x2){v1[0], v1[1]}), d = gelu_pk((f32x2){v1[2], v1[3]});
                        v0 = (f32x4){a.x, a.y, b.x, b.y}; v1 = (f32x4){c.x, c.y, d.x, d.y}; }
                    if (ACT == 2) {
#pragma unroll
                        for (int j = 0; j < 4; ++j) { v0[j] = 0.5f * v0[j] * (1.0f + erff(v0[j] * 0.70710678f)); v1[j] = 0.5f * v1[j] * (1.0f + erff(v1[j] * 0.70710678f)); } }
                    u32x4 w; w.x = cvt_pk_bf16(v0[0], v0[1]); w.y = cvt_pk_bf16(v0[2], v0[3]); w.z = cvt_pk_bf16(v1[0], v1[1]); w.w = cvt_pk_bf16(v1[2], v1[3]);
                    *(u32x4*)(rowp + bj * HALF) = w; } }
    }
};

struct PanelStats {
    unsigned* xbuf;
    unsigned* cnt;
    unsigned* tmo;
    int ntn; float eps;
    unsigned code;
    __device__ __forceinline__ bool run(const f32x4 (&v)[2][2][4][2], const Unit& u, int wr, int wc, int fr, int fq, PG8_LAS unsigned char* lds, int wid, int lane) const {
        typedef float f32x2v __attribute__((ext_vector_type(2)));
        PG8_LAS f32x2v* P = (PG8_LAS f32x2v*)lds;
        PG8_LAS f32x2v* S = (PG8_LAS f32x2v*)(lds + 8192);
        PG8_LAS unsigned* flag = (PG8_LAS unsigned*)(lds + 8192 + 2048);
#pragma unroll
        for (int ai = 0; ai < 2; ++ai)
#pragma unroll
            for (int m = 0; m < 4; ++m) {
                float s = 0.f;
#pragma unroll
                for (int bj = 0; bj < 2; ++bj)
#pragma unroll
                    for (int n = 0; n < 2; ++n) { const f32x4 x = v[ai][bj][m][n]; s += (x[0] + x[1]) + (x[2] + x[3]); }
                s += __shfl_xor(s, 16); s += __shfl_xor(s, 32);
                const float mw = s * (1.0f / 64.0f); float q = 0.f;
#pragma unroll
                for (int bj = 0; bj < 2; ++bj)
#pragma unroll
                    for (int n = 0; n < 2; ++n) { const f32x4 d = v[ai][bj][m][n] - mw; q += (d[0] * d[0] + d[1] * d[1]) + (d[2] * d[2] + d[3] * d[3]); }
                q += __shfl_xor(q, 16); q += __shfl_xor(q, 32);
                if (fq == 0) P[(ai * HALF + wr * 64 + m * 16 + fr) * 4 + wc] = (f32x2v){mw, q};
            }
        asm volatile("s_waitcnt lgkmcnt(0)" ::: "memory"); __builtin_amdgcn_s_barrier(); asm volatile("" ::: "memory");
#if defined(BROKEN_NO_WAIT)
        if (blockIdx.x >= 64) { const long long t0 = clock64(); while (clock64() - t0 < 60000) __builtin_amdgcn_s_sleep(8); }
#endif
        const int row = wid * 32 + (lane & 31);
        if (lane < 32) {
            const f32x2v a = P[row * 4 + 0], b = P[row * 4 + 1], c = P[row * 4 + 2], d = P[row * 4 + 3];
            const float mt = (a.x + b.x + c.x + d.x) * 0.25f;
            const float da = a.x - mt, db = b.x - mt, dc = c.x - mt, dd = d.x - mt;
            const float m2 = (a.y + b.y) + (c.y + d.y) + 64.0f * ((da * da + db * db) + (dc * dc + dd * dd));
            unsigned long long* slot = (unsigned long long*)xbuf + ((size_t)(u.pm * BM + row) * 4 + u.pn);
            __hip_atomic_store(slot, ((unsigned long long)__float_as_uint(m2) << 32) | __float_as_uint(mt), __ATOMIC_RELAXED, __HIP_MEMORY_SCOPE_AGENT);
        }
        asm volatile("s_waitcnt vmcnt(0)" ::: "memory");
        if (lane == 0) __hip_atomic_fetch_add(cnt + 64 * u.pm, 1u, __ATOMIC_RELAXED, __HIP_MEMORY_SCOPE_AGENT);
        if (wid == 0) {
            bool dead = false; const unsigned long long t0 = __builtin_amdgcn_s_memrealtime(); const unsigned want = 8u * (unsigned)ntn;
            for (;;) {
#if defined(BROKEN_NO_WAIT)
                break;
#endif
                if ((unsigned)__builtin_amdgcn_readfirstlane(__hip_atomic_load(cnt + 64 * u.pm, __ATOMIC_RELAXED, __HIP_MEMORY_SCOPE_AGENT)) >= want) break;
                if (__builtin_amdgcn_s_memrealtime() - t0 > 2000000ull) {
                    if (lane == 0) { unsigned expect = 0u; __hip_atomic_compare_exchange_strong(tmo + 1, &expect, code | (unsigned)(u.pm & 0xff), __ATOMIC_RELAXED, __ATOMIC_RELAXED, __HIP_MEMORY_SCOPE_AGENT);
                                     __hip_atomic_store(tmo, 1u, __ATOMIC_RELAXED, __HIP_MEMORY_SCOPE_AGENT); }
                    dead = true; break; }
                __builtin_amdgcn_s_sleep(2);
            }
            __builtin_amdgcn_fence(__ATOMIC_ACQUIRE, "agent");
            if (lane == 0) flag[0] = dead ? 1u : 0u;
        }
        asm volatile("s_waitcnt vmcnt(0) lgkmcnt(0)" ::: "memory"); __builtin_amdgcn_s_barrier(); asm volatile("" ::: "memory");
        const bool bad = flag[0] != 0u;
        if (lane < 32) {
            const unsigned long long* slot = (const unsigned long long*)xbuf + (size_t)(u.pm * BM + row) * 4; float mt[4], m2[4]; float ms = 0.f;
#pragma unroll
            for (int t = 0; t < 4; ++t) { if (t < ntn) { const unsigned long long w = __hip_atomic_load(slot + t, __ATOMIC_RELAXED, __HIP_MEMORY_SCOPE_AGENT); mt[t] = __uint_as_float((unsigned)w); m2[t] = __uint_as_float((unsigned)(w >> 32)); } else { mt[t] = 0.f; m2[t] = 0.f; } ms += mt[t]; }
            const float mean = ms / (float)ntn; float q = 0.f;
#pragma unroll
            for (int t = 0; t < 4; ++t) if (t < ntn) { const float dm = mt[t] - mean; q += m2[t] + 256.0f * dm * dm; }
            S[row] = (f32x2v){mean, 1.0f / sqrtf(q / (256.0f * (float)ntn) + eps)};
        }
        asm volatile("s_waitcnt lgkmcnt(0)" ::: "memory"); __builtin_amdgcn_s_barrier(); asm volatile("" ::: "memory");
        return bad;
    }
};
struct EpiLnRes {
    static constexpr bool PERM = false, AFTER_DRAIN = true;
    const float* base; float* out; int ldc; const float* bias; PanelStats st; unsigned poison;
    __device__ __forceinline__ void refuse(size_t i0, size_t stride, int M, int N) const { const float q = __builtin_nanf(""); for (size_t i = i0; i < (size_t)M * N; i += stride) out[(i / N) * ldc + i % N] = q;
        if (i0 == 0) { unsigned expect = 0u; __hip_atomic_compare_exchange_strong(st.tmo + 1, &expect, 0x7f0u, __ATOMIC_RELAXED, __ATOMIC_RELAXED, __HIP_MEMORY_SCOPE_AGENT); __hip_atomic_store(st.tmo, 1u, __ATOMIC_RELAXED, __HIP_MEMORY_SCOPE_AGENT); } }
    __device__ __forceinline__ void fused(f32x4 (&acc)[2][2][4][2], const Unit& u, int wr, int wc, int fr, int fq, PG8_LAS unsigned char* lds, int wid, int lane) const {
        typedef float f32x2v __attribute__((ext_vector_type(2)));
        const PG8_LAS f32x2v* S = (const PG8_LAS f32x2v*)(lds + 8192);
        const int col0 = u.pn * BM + wc * 32 + 4 * fq;
#pragma unroll
        for (int bj = 0; bj < 2; ++bj)
#pragma unroll
            for (int n = 0; n < 2; ++n) { const f32x4 bv = bias ? *(const f32x4*)(bias + col0 + bj * HALF + n * 16) : (f32x4){0.f, 0.f, 0.f, 0.f};
#pragma unroll
                for (int ai = 0; ai < 2; ++ai)
#pragma unroll
                    for (int m = 0; m < 4; ++m) acc[ai][bj][m][n] += bv; }
        const bool bad = st.run(acc, u, wr, wc, fr, fq, lds, wid, lane) || poison != 0u;
        const float qnan = __builtin_nanf("");
#pragma unroll
        for (int ai = 0; ai < 2; ++ai)
#pragma unroll
            for (int m = 0; m < 4; ++m) { const int r = ai * HALF + wr * 64 + m * 16 + fr; const f32x2v sr = S[r]; const size_t off = (size_t)(u.pm * BM + r) * ldc + col0;
#pragma unroll
                for (int bj = 0; bj < 2; ++bj)
#pragma unroll
                    for (int n = 0; n < 2; ++n) { const f32x4 bs = *(const f32x4*)(base + off + bj * HALF + n * 16); f32x4 o = bs + (acc[ai][bj][m][n] - sr.x) * sr.y;
                        if (bad) o = (f32x4){qnan, qnan, qnan, qnan}; *(f32x4*)(out + off + bj * HALF + n * 16) = o; }
                asm volatile("" ::: "memory"); }
    }
};
struct EpiLnResLn {
    static constexpr bool PERM = false, AFTER_DRAIN = true;
    const float* base; float* out; bf16_t* xn; int ldc; const float* bias; PanelStats st1, st2; unsigned poison;
    __device__ __forceinline__ void refuse(size_t i0, size_t stride, int M, int N) const { const float q = __builtin_nanf(""); for (size_t i = i0; i < (size_t)M * N; i += stride) { const size_t o = (i / N) * ldc + i % N; out[o] = q; xn[o] = (bf16_t)0x7fc0u; }
        if (i0 == 0) { unsigned expect = 0u; __hip_atomic_compare_exchange_strong(st1.tmo + 1, &expect, 0x7f0u, __ATOMIC_RELAXED, __ATOMIC_RELAXED, __HIP_MEMORY_SCOPE_AGENT); __hip_atomic_store(st1.tmo, 1u, __ATOMIC_RELAXED, __HIP_MEMORY_SCOPE_AGENT); } }
    __device__ __forceinline__ void fused(f32x4 (&acc)[2][2][4][2], const Unit& u, int wr, int wc, int fr, int fq, PG8_LAS unsigned char* lds, int wid, int lane) const {
        typedef float f32x2v __attribute__((ext_vector_type(2))); typedef unsigned u32x2v __attribute__((ext_vector_type(2)));
        const PG8_LAS f32x2v* S = (const PG8_LAS f32x2v*)(lds + 8192);
        const int col0 = u.pn * BM + wc * 32 + 4 * fq;
#pragma unroll
        for (int bj = 0; bj < 2; ++bj)
#pragma unroll
            for (int n = 0; n < 2; ++n) { const f32x4 bv = bias ? *(const f32x4*)(bias + col0 + bj * HALF + n * 16) : (f32x4){0.f, 0.f, 0.f, 0.f};
#pragma unroll
                for (int ai = 0; ai < 2; ++ai)
#pragma unroll
                    for (int m = 0; m < 4; ++m) acc[ai][bj][m][n] += bv; }
        bool bad = st1.run(acc, u, wr, wc, fr, fq, lds, wid, lane) || poison != 0u;
        const float qnan = __builtin_nanf("");
#pragma unroll
        for (int ai = 0; ai < 2; ++ai)
#pragma unroll
            for (int m = 0; m < 4; ++m) { const int r = ai * HALF + wr * 64 + m * 16 + fr; const f32x2v sr = S[r]; const size_t off = (size_t)(u.pm * BM + r) * ldc + col0;
#pragma unroll
                for (int bj = 0; bj < 2; ++bj)
#pragma unroll
                    for (int n = 0; n < 2; ++n) { const f32x4 bs = *(const f32x4*)(base + off + bj * HALF + n * 16); acc[ai][bj][m][n] = bs + (acc[ai][bj][m][n] - sr.x) * sr.y; }
                asm volatile("" : "+v"(acc[ai][0][m][0]), "+v"(acc[ai][0][m][1]), "+v"(acc[ai][1][m][0]), "+v"(acc[ai][1][m][1]));
                if (m & 1) asm volatile("" ::: "memory"); }
        const bool bad1 = bad;
        bad = st2.run(acc, u, wr, wc, fr, fq, lds, wid, lane) || bad;
#pragma unroll
        for (int ai = 0; ai < 2; ++ai)
#pragma unroll
            for (int m = 0; m < 4; ++m) { const int r = ai * HALF + wr * 64 + m * 16 + fr; const f32x2v sr = S[r]; const size_t off = (size_t)(u.pm * BM + r) * ldc + col0;
#pragma unroll
                for (int bj = 0; bj < 2; ++bj)
#pragma unroll
                    for (int n = 0; n < 2; ++n) { const f32x4 x1 = acc[ai][bj][m][n]; *(f32x4*)(out + off + bj * HALF + n * 16) = bad1 ? (f32x4){qnan, qnan, qnan, qnan} : x1;
                        const f32x4 o = (x1 - sr.x) * sr.y; u32x2v w; w.x = cvt_pk_bf16(o[0], o[1]); w.y = cvt_pk_bf16(o[2], o[3]);
                        if (bad) { w.x = 0x7fc07fc0u; w.y = 0x7fc07fc0u; } *(u32x2v*)(xn + off + bj * HALF + n * 16) = w; }
                asm volatile("" ::: "memory"); }
    }
};

template <class Epi, class Sched, bool STAMP = false, bool AOVL = false>
__device__ __forceinline__ void gemm_phase(PG8_LAS unsigned char* lds, const Gemm g, const Sched& S, const Epi& E, unsigned long long* stamps) {
    int tid_ = threadIdx.x; asm volatile("" : "+v"(tid_));
    const int tid = tid_, wid = __builtin_amdgcn_readfirstlane(tid >> 6), lane = tid & 63, wr = wid >> 2, wc = wid & 3, fr = lane & 15, fq = lane >> 4;
    const int K = g.K, nt = K / BK;
    int ts_lo = 0, ts_hi = 0, nts = 0; const unsigned long long rt_entry = STAMP ? (unsigned long long)wall_clock64() : 0ull;
#define PG8_STAMP() do { if (STAMP && wid == 0 && nts < 64) { const unsigned long long _c = (unsigned long long)clock64(); \
        ts_lo = (lane == nts) ? (int)(unsigned)_c : ts_lo; ts_hi = (lane == nts) ? (int)(unsigned)(_c >> 32) : ts_hi; ++nts; } } while (0)
    PG8_STAMP();
    unsigned voffA[2], voffB[2];
#pragma unroll
    for (int i = 0; i < 2; ++i) { int R, C; stage_rc(tid * 16 + i * 8192, R, C); const int Rb = Epi::PERM ? ((R & ~31) + perm32(R & 31)) : R;
        const int Ra = AOVL ? R - 2 * (R >> 6) : R;
        voffA[i] = (unsigned)(Ra * K + C) * 2u; voffB[i] = (unsigned)(Rb * K + C) * 2u; }
    const size_t kstep = (size_t)(BK * 2);
    const size_t hstep = (size_t)HALF * K * 2;
    const size_t tstep = 2 * hstep;
    const size_t hstepA = AOVL ? (size_t)124 * K * 2 : hstep, tstepA = 2 * hstepA;
    const unsigned ldsw = (unsigned)wid * 1024u;
    const int aoff = lds_byte(wr * 64 + fr, fq * 8), boff = lds_byte(wc * 32 + fr, fq * 8);
#define PG8_SA(b, h) (((b) * 2 + (h)) * HTB)
#define PG8_SB(b, h) ((4 + (b) * 2 + (h)) * HTB)
#define PG8_STAGE(bufoff, gbase, voff) do { _Pragma("unroll") for (int _i = 0; _i < 2; ++_i) \
        __builtin_amdgcn_global_load_lds((const unsigned*)((const char*)(gbase) + (voff)[_i]), (PG8_LAS unsigned*)(lds + (bufoff) + ldsw + _i * 8192), 16, 0, 0); } while (0)
#define PG8_LDA(dst, b, h) do { _Pragma("unroll") for (int m = 0; m < 4; ++m) _Pragma("unroll") for (int k = 0; k < 2; ++k) dst[m][k] = *(const PG8_LAS bf16x8*)(lds + PG8_SA(b, h) + aoff + m * 2048 + k * 1024); } while (0)
#define PG8_LDB(dst, b, h) do { _Pragma("unroll") for (int n = 0; n < 2; ++n) _Pragma("unroll") for (int k = 0; k < 2; ++k) dst[n][k] = *(const PG8_LAS bf16x8*)(lds + PG8_SB(b, h) + boff + n * 2048 + k * 1024); } while (0)
#define PG8_MMA(ai, bj, At, Bt) do { __builtin_amdgcn_s_setprio(1); _Pragma("unroll") for (int m = 0; m < 4; ++m) _Pragma("unroll") for (int n = 0; n < 2; ++n) _Pragma("unroll") for (int k = 0; k < 2; ++k) \
        acc[ai][bj][m][n] = __builtin_amdgcn_mfma_f32_16x16x32_bf16(Bt[n][k], At[m][k], acc[ai][bj][m][n], 0, 0, 0); __builtin_amdgcn_s_setprio(0); } while (0)
#define PG8_WAIT_V(n) asm volatile("s_waitcnt vmcnt(" #n ")" ::: "memory")
#define PG8_WAIT_L(n) asm volatile("s_waitcnt lgkmcnt(" #n ")" ::: "memory")
#define PG8_BAR __builtin_amdgcn_s_barrier()
#define PG8_SCHED __builtin_amdgcn_sched_barrier(0)
    Unit cur, nxt; int ui = 0;
    if (!S.next(0, cur)) return;
    f32x4 acc[2][2][4][2];
#pragma unroll
    for (int a = 0; a < 2; ++a)
#pragma unroll
        for (int b = 0; b < 2; ++b)
#pragma unroll
            for (int m = 0; m < 4; ++m)
#pragma unroll
                for (int n = 0; n < 2; ++n) acc[a][b][m][n] = (f32x4){0.f, 0.f, 0.f, 0.f};
    bf16x8 At[4][2], B0[2][2], B1[2][2];
    const char* cA = (const char*)g.A + (size_t)cur.pm * tstepA; const char* cB = (const char*)g.Bt + (size_t)cur.pn * tstep;
    S.a_ready(cur);
    PG8_STAGE(PG8_SB(0, 0), cB, voffB); PG8_STAGE(PG8_SA(0, 0), cA, voffA); PG8_STAGE(PG8_SB(0, 1), cB + hstep, voffB); PG8_STAGE(PG8_SA(0, 1), cA + hstepA, voffA);
    if (wr == 1) PG8_BAR;
    PG8_WAIT_V(4); PG8_BAR;
    PG8_STAGE(PG8_SB(1, 0), cB + kstep, voffB); PG8_STAGE(PG8_SA(1, 0), cA + kstep, voffA); PG8_STAGE(PG8_SB(1, 1), cB + hstep + kstep, voffB);
    PG8_WAIT_V(6); PG8_BAR;
    PG8_STAMP();
    for (;;) {
        const bool has_next = S.next(ui + 1, nxt);
        const char* nA = has_next ? (const char*)g.A + (size_t)nxt.pm * tstepA : cA; const char* nB = has_next ? (const char*)g.Bt + (size_t)nxt.pn * tstep : cB;
        for (int t = 0; t < nt; t += 2) {
            const bool last = (t == nt - 2);
            const char* a1 = cA + (size_t)(t + 1) * kstep;
            const char* a2 = last ? nA : cA + (size_t)(t + 2) * kstep; const char* b2 = last ? nB : cB + (size_t)(t + 2) * kstep;
            const char* a3 = a2 + kstep; const char* b3 = b2 + kstep;
            if (last && has_next) S.a_ready(nxt);
            PG8_LDB(B0, 0, 0); PG8_SCHED; PG8_LDA(At, 0, 0); PG8_STAGE(PG8_SA(1, 1), a1 + hstepA, voffA);
            PG8_WAIT_L(8); PG8_BAR; PG8_WAIT_L(0); PG8_MMA(0, 0, At, B0); PG8_BAR; PG8_SCHED;
            PG8_LDB(B1, 0, 1); PG8_STAGE(PG8_SB(0, 0), b2, voffB);
            PG8_BAR; PG8_WAIT_L(0); PG8_MMA(0, 1, At, B1); PG8_BAR;
            PG8_LDA(At, 0, 1); PG8_STAGE(PG8_SA(0, 0), a2, voffA);
            PG8_BAR; PG8_WAIT_L(0); PG8_MMA(1, 0, At, B0); PG8_BAR; PG8_SCHED;
            PG8_STAGE(PG8_SB(0, 1), b2 + hstep, voffB);
            PG8_WAIT_V(6); PG8_BAR; PG8_MMA(1, 1, At, B1); PG8_BAR;
            PG8_LDB(B0, 1, 0); PG8_SCHED; PG8_LDA(At, 1, 0); PG8_STAGE(PG8_SA(0, 1), a2 + hstepA, voffA);
            PG8_WAIT_L(8); PG8_BAR; PG8_WAIT_L(0); PG8_MMA(0, 0, At, B0); PG8_BAR; PG8_SCHED;
            PG8_LDB(B1, 1, 1); PG8_STAGE(PG8_SB(1, 0), b3, voffB);
            PG8_BAR; PG8_WAIT_L(0); PG8_MMA(0, 1, At, B1); PG8_BAR;
            PG8_LDA(At, 1, 1); PG8_STAGE(PG8_SA(1, 0), a3, voffA);
            PG8_BAR; PG8_WAIT_L(0); PG8_MMA(1, 0, At, B0); PG8_BAR; PG8_SCHED;
            PG8_STAGE(PG8_SB(1, 1), b3 + hstep, voffB);
            PG8_WAIT_V(6); PG8_BAR; PG8_MMA(1, 1, At, B1); PG8_BAR;
        }
        PG8_STAMP();
        if constexpr (!Epi::AFTER_DRAIN) { E(acc, cur, wr, wc, fr, fq); S.done(cur); }
        PG8_STAMP();
        if (!has_next) break;
#pragma unroll
        for (int a = 0; a < 2; ++a)
#pragma unroll
            for (int b = 0; b < 2; ++b)
#pragma unroll
                for (int m = 0; m < 4; ++m)
#pragma unroll
                    for (int n = 0; n < 2; ++n) acc[a][b][m][n] = (f32x4){0.f, 0.f, 0.f, 0.f};
        cur = nxt; cA = nA; cB = nB; ++ui;
    }
    PG8_WAIT_V(0);
    if (wr == 0) PG8_BAR;
    PG8_BAR;
    if constexpr (Epi::AFTER_DRAIN) { E.fused(acc, cur, wr, wc, fr, fq, lds, wid, lane); S.done(cur); }
    PG8_STAMP();
    if (STAMP && wid == 0) { stamps[lane] = lane < nts ? (((unsigned long long)(unsigned)ts_hi << 32) | (unsigned)ts_lo) : 0ull;
        if (lane == 62) stamps[62] = rt_entry; if (lane == 63) stamps[63] = (unsigned long long)wall_clock64(); }
#undef PG8_STAMP
#undef PG8_SA
#undef PG8_SB
#undef PG8_STAGE
#undef PG8_LDA
#undef PG8_LDB
#undef PG8_MMA
#undef PG8_WAIT_V
#undef PG8_WAIT_L
#undef PG8_BAR
#undef PG8_SCHED
}
}
namespace pg8 {
template <class T, class = void> struct keeps_acc { static constexpr bool v = false; };
template <class T> struct keeps_acc<T, decltype((void)T::KEEP_ACC)> { static constexpr bool v = T::KEEP_ACC; };
template <class Epi, class Sched, bool ALIGN_EPI = false, bool SP2 = false, bool AOVL = false>
__device__ __forceinline__ void gemm_phase2(PG8_LAS unsigned char* lds, const Gemm g, const Sched& S, const Epi& E) {
    int tid_ = threadIdx.x; asm volatile("" : "+v"(tid_));
    const int tid = tid_, wid = __builtin_amdgcn_readfirstlane(tid >> 6), lane = tid & 63, wr = wid >> 2, wc = wid & 3, fr = lane & 15, fq = lane >> 4;
    const int K = g.K, nt = K / BK;
    unsigned voffA[2], voffB[2];
#pragma unroll
    for (int i = 0; i < 2; ++i) { int R, C; stage_rc(tid * 16 + i * 8192, R, C); const int Rb = Epi::PERM ? ((R & ~31) + perm32(R & 31)) : R;
        const int Ra = AOVL ? R - 2 * (R >> 6) : R;
        voffA[i] = (unsigned)(Ra * K + C) * 2u; voffB[i] = (unsigned)(Rb * K + C) * 2u; }
    const size_t kstep = (size_t)(BK * 2);
    const size_t hstep = (size_t)HALF * K * 2;
    const size_t tstep = 2 * hstep;
    const size_t hstepA = AOVL ? (size_t)124 * K * 2 : hstep, tstepA = 2 * hstepA;
    const unsigned ldsw = (unsigned)wid * 1024u;
    const int aoff = lds_byte(wr * 64 + fr, fq * 8), boff = lds_byte(wc * 32 + fr, fq * 8);
#define PG8_SA(b, h) (((b) * 2 + (h)) * HTB)
#define PG8_SB(b, h) ((4 + (b) * 2 + (h)) * HTB)
#define PG8_STAGE(bufoff, gbase, voff) do { _Pragma("unroll") for (int _i = 0; _i < 2; ++_i) \
        __builtin_amdgcn_global_load_lds((const unsigned*)((const char*)(gbase) + (voff)[_i]), (PG8_LAS unsigned*)(lds + (bufoff) + ldsw + _i * 8192), 16, 0, 0); } while (0)
#define PG8_LDA(dst, b, h) do { _Pragma("unroll") for (int m = 0; m < 4; ++m) _Pragma("unroll") for (int k = 0; k < 2; ++k) dst[m][k] = *(const PG8_LAS bf16x8*)(lds + PG8_SA(b, h) + aoff + m * 2048 + k * 1024); } while (0)
#define PG8_LDB(dst, b, h) do { _Pragma("unroll") for (int n = 0; n < 2; ++n) _Pragma("unroll") for (int k = 0; k < 2; ++k) dst[n][k] = *(const PG8_LAS bf16x8*)(lds + PG8_SB(b, h) + boff + n * 2048 + k * 1024); } while (0)
#define PG8_MMA(ai, bj, At, Bt) do { __builtin_amdgcn_s_setprio(1); _Pragma("unroll") for (int m = 0; m < 4; ++m) _Pragma("unroll") for (int n = 0; n < 2; ++n) _Pragma("unroll") for (int k = 0; k < 2; ++k) \
        acc[ai][bj][m][n] = __builtin_amdgcn_mfma_f32_16x16x32_bf16(Bt[n][k], At[m][k], acc[ai][bj][m][n], 0, 0, 0); __builtin_amdgcn_s_setprio(0); } while (0)
#define PG8_WAIT_V(n) asm volatile("s_waitcnt vmcnt(" #n ")" ::: "memory")
#define PG8_WAIT_L(n) asm volatile("s_waitcnt lgkmcnt(" #n ")" ::: "memory")
#define PG8_BAR __builtin_amdgcn_s_barrier()
#define PG8_SCHED __builtin_amdgcn_sched_barrier(0)
    Unit cur, nxt; int ui = 0;
    if (!S.next(0, cur)) return;
    f32x4 acc[2][2][4][2];
#pragma unroll
    for (int a = 0; a < 2; ++a)
#pragma unroll
        for (int b = 0; b < 2; ++b)
#pragma unroll
            for (int m = 0; m < 4; ++m)
#pragma unroll
                for (int n = 0; n < 2; ++n) acc[a][b][m][n] = (f32x4){0.f, 0.f, 0.f, 0.f};
    bf16x8 At[4][2], B0[2][2], B1[2][2];
    const char* cA = (const char*)g.A + (size_t)cur.pm * tstepA; const char* cB = (const char*)g.Bt + (size_t)cur.pn * tstep;
    S.a_ready(cur);
    if constexpr (SP2) {
        PG8_STAGE(PG8_SB(0, 0), cB, voffB); PG8_STAGE(PG8_SB(0, 1), cB + hstep, voffB); PG8_STAGE(PG8_SA(0, 0), cA, voffA); PG8_STAGE(PG8_SA(0, 1), cA + hstepA, voffA);
        if (wr == 1) PG8_BAR;
        PG8_WAIT_V(2); PG8_BAR;
        PG8_STAGE(PG8_SB(1, 0), cB + kstep, voffB); PG8_STAGE(PG8_SA(1, 0), cA + kstep, voffA); PG8_STAGE(PG8_SB(1, 1), cB + hstep + kstep, voffB);
        PG8_WAIT_V(6); PG8_BAR;
    } else {
        PG8_STAGE(PG8_SB(0, 0), cB, voffB); PG8_STAGE(PG8_SA(0, 0), cA, voffA); PG8_STAGE(PG8_SB(0, 1), cB + hstep, voffB); PG8_STAGE(PG8_SA(0, 1), cA + hstepA, voffA);
        if (wr == 1) PG8_BAR;
        PG8_WAIT_V(4); PG8_BAR;
        PG8_STAGE(PG8_SB(1, 0), cB + kstep, voffB); PG8_STAGE(PG8_SA(1, 0), cA + kstep, voffA); PG8_STAGE(PG8_SB(1, 1), cB + hstep + kstep, voffB);
        PG8_WAIT_V(6); PG8_BAR;
    }
    for (;;) {
        const bool has_next = S.next(ui + 1, nxt);
        const char* nA = has_next ? (const char*)g.A + (size_t)nxt.pm * tstepA : cA; const char* nB = has_next ? (const char*)g.Bt + (size_t)nxt.pn * tstep : cB;
        for (int t = 0; t < nt; t += 2) {
            const bool last = (t == nt - 2);
            const char* a1 = cA + (size_t)(t + 1) * kstep;
            const char* a2 = last ? nA : cA + (size_t)(t + 2) * kstep; const char* b2 = last ? nB : cB + (size_t)(t + 2) * kstep;
            const char* a3 = a2 + kstep; const char* b3 = b2 + kstep;
            if (last && has_next) S.a_ready(nxt);
            if constexpr (SP2) {
            PG8_LDB(B0, 0, 0); PG8_LDB(B1, 0, 1); PG8_SCHED; PG8_LDA(At, 0, 0); PG8_STAGE(PG8_SA(1, 1), a1 + hstepA, voffA);
            PG8_WAIT_V(8); PG8_WAIT_L(0); PG8_BAR; PG8_MMA(0, 0, At, B0); PG8_MMA(0, 1, At, B1); PG8_BAR; PG8_SCHED;
            PG8_LDA(At, 0, 1); PG8_STAGE(PG8_SB(0, 0), b2, voffB); PG8_STAGE(PG8_SB(0, 1), b2 + hstep, voffB); PG8_STAGE(PG8_SA(0, 0), a2, voffA);
            PG8_WAIT_V(8); PG8_WAIT_L(0); PG8_BAR; PG8_MMA(1, 0, At, B0); PG8_MMA(1, 1, At, B1); PG8_BAR; PG8_SCHED;
            PG8_LDB(B0, 1, 0); PG8_LDB(B1, 1, 1); PG8_SCHED; PG8_LDA(At, 1, 0); PG8_STAGE(PG8_SA(0, 1), a2 + hstepA, voffA);
            PG8_WAIT_V(8); PG8_WAIT_L(0); PG8_BAR; PG8_MMA(0, 0, At, B0); PG8_MMA(0, 1, At, B1); PG8_BAR; PG8_SCHED;
            PG8_LDA(At, 1, 1); PG8_STAGE(PG8_SB(1, 0), b3, voffB); PG8_STAGE(PG8_SB(1, 1), b3 + hstep, voffB); PG8_STAGE(PG8_SA(1, 0), a3, voffA);
            PG8_WAIT_V(8); PG8_WAIT_L(0); PG8_BAR; PG8_MMA(1, 0, At, B0); PG8_MMA(1, 1, At, B1); PG8_BAR; PG8_SCHED;
            } else {
            PG8_LDB(B0, 0, 0); PG8_SCHED; PG8_LDA(At, 0, 0); PG8_STAGE(PG8_SA(1, 1), a1 + hstepA, voffA);
            PG8_WAIT_L(8); PG8_BAR; PG8_WAIT_L(0); PG8_MMA(0, 0, At, B0); PG8_BAR; PG8_SCHED;
            PG8_LDB(B1, 0, 1); PG8_STAGE(PG8_SB(0, 0), b2, voffB);
            PG8_BAR; PG8_WAIT_L(0); PG8_MMA(0, 1, At, B1); PG8_BAR;
            PG8_LDA(At, 0, 1); PG8_STAGE(PG8_SA(0, 0), a2, voffA);
            PG8_BAR; PG8_WAIT_L(0); PG8_MMA(1, 0, At, B0); PG8_BAR; PG8_SCHED;
            PG8_STAGE(PG8_SB(0, 1), b2 + hstep, voffB);
            PG8_WAIT_V(6); PG8_BAR; PG8_MMA(1, 1, At, B1); PG8_BAR;
            PG8_LDB(B0, 1, 0); PG8_SCHED; PG8_LDA(At, 1, 0); PG8_STAGE(PG8_SA(0, 1), a2 + hstepA, voffA);
            PG8_WAIT_L(8); PG8_BAR; PG8_WAIT_L(0); PG8_MMA(0, 0, At, B0); PG8_BAR; PG8_SCHED;
            PG8_LDB(B1, 1, 1); PG8_STAGE(PG8_SB(1, 0), b3, voffB);
            PG8_BAR; PG8_WAIT_L(0); PG8_MMA(0, 1, At, B1); PG8_BAR;
            PG8_LDA(At, 1, 1); PG8_STAGE(PG8_SA(1, 0), a3, voffA);
            PG8_BAR; PG8_WAIT_L(0); PG8_MMA(1, 0, At, B0); PG8_BAR; PG8_SCHED;
            PG8_STAGE(PG8_SB(1, 1), b3 + hstep, voffB);
            PG8_WAIT_V(6); PG8_BAR; PG8_MMA(1, 1, At, B1); PG8_BAR;
            }
        }
        if constexpr (ALIGN_EPI) { if (wr == 0) PG8_BAR; }
        if constexpr (!Epi::AFTER_DRAIN) { E(acc, cur, wr, wc, fr, fq); S.done(cur); }
        if (!has_next) break;
        bool keep_ = false; if constexpr (keeps_acc<Epi>::v) keep_ = E.keep(cur);
        if (!keep_) {
#pragma unroll
        for (int a = 0; a < 2; ++a)
#pragma unroll
            for (int b = 0; b < 2; ++b)
#pragma unroll
                for (int m = 0; m < 4; ++m)
#pragma unroll
                    for (int n = 0; n < 2; ++n) acc[a][b][m][n] = (f32x4){0.f, 0.f, 0.f, 0.f};
        }
        cur = nxt; cA = nA; cB = nB; ++ui;
        if constexpr (ALIGN_EPI) { if (wr == 1) PG8_BAR; }
    }
    PG8_WAIT_V(0);
    if constexpr (!ALIGN_EPI) { if (wr == 0) PG8_BAR; }
    PG8_BAR;
    if constexpr (Epi::AFTER_DRAIN) { E.fused(acc, cur, wr, wc, fr, fq, lds, wid, lane); S.done(cur); }
#undef PG8_SA
#undef PG8_SB
#undef PG8_STAGE
#undef PG8_LDA
#undef PG8_LDB
#undef PG8_MMA
#undef PG8_WAIT_V
#undef PG8_WAIT_L
#undef PG8_BAR
#undef PG8_SCHED
}

}
#define XB_TMO      128
#define XB_XCNT(j)  (256  + 64 * (j))
#define XB_XSUB(j)  (1280 + 64 * (j))
#define XB_XGEN(j)  (2304 + 64 * (j))
#define XB_TOP      3328
#define XB_TOPGEN   3392
#define XCD_BAR_WORDS 3456
#define XB_SPIN_CAP (1u << 22)
#define LAS __attribute__((address_space(3)))

__device__ __forceinline__ unsigned xb_ld(unsigned* p)              { return __hip_atomic_load(p, __ATOMIC_RELAXED, __HIP_MEMORY_SCOPE_AGENT); }
__device__ __forceinline__ unsigned xb_add(unsigned* p, unsigned v) { return __hip_atomic_fetch_add(p, v, __ATOMIC_RELAXED, __HIP_MEMORY_SCOPE_AGENT); }
__device__ __forceinline__ unsigned xb_xcc_id() { return (unsigned)__builtin_amdgcn_s_getreg((3 << 11) | 20) & 0xFu; }
#define XB_SPIN(cond, bar) do { unsigned _sp = 0; while (cond) { __builtin_amdgcn_s_sleep(1); \
    if ((++_sp & 255u) == 0u) { if (xb_ld(&(bar)[XB_TMO])) break; if (_sp > XB_SPIN_CAP) { atomicAdd(&(bar)[XB_TMO], 1u); break; } } } } while (0)

struct XcdBarrier {
    unsigned* bar; unsigned x;
    volatile LAS unsigned* st;
};

__device__ __forceinline__ XcdBarrier xcd_barrier_post(unsigned* bar, volatile LAS unsigned* st) {
    XcdBarrier b; b.bar = bar; b.x = xb_xcc_id(); b.st = st;
    if (threadIdx.x == 0) (void)xb_add(&bar[XB_XCNT(b.x)], 1u);
    return b;
}
__device__ __forceinline__ void xcd_barrier_complete(unsigned* bar, unsigned x, unsigned& nloc, unsigned& nx) {
    const unsigned G = gridDim.x * gridDim.y * gridDim.z;
    unsigned sum, cnt, mine, sp = 0u;
    for (;;) {
        sum = 0u; cnt = 0u; mine = 0u;
#pragma unroll
        for (unsigned j = 0; j < 16; ++j) { const unsigned c = xb_ld(&bar[XB_XCNT(j)]); sum += c; cnt += (c > 0u) ? 1u : 0u; mine = (j == x) ? c : mine; }
        if (sum == G) break;
        __builtin_amdgcn_s_sleep(1);
        if ((++sp & 255u) == 0u) { if (xb_ld(&bar[XB_TMO])) break; if (sp > XB_SPIN_CAP) { atomicAdd(&bar[XB_TMO], 1u); break; } }
    }
    nloc = mine > 0u ? mine : 1u; nx = cnt > 0u ? cnt : 1u;
}

__device__ __forceinline__ void xcd_barrier(const XcdBarrier& b) {
    asm volatile("s_waitcnt vmcnt(0)" ::: "memory");
    __syncthreads();
    if (threadIdx.x == 0) {
        unsigned* bar = b.bar;
        __builtin_amdgcn_s_waitcnt(0);
        unsigned nloc = b.st[0], nx = b.st[1];
        if (nloc == 0u) { xcd_barrier_complete(bar, b.x, nloc, nx); b.st[0] = nloc; b.st[1] = nx; }
        const unsigned old = xb_add(&bar[XB_XSUB(b.x)], 1u);
        const unsigned gen = old / nloc;
        if (old + 1u == (gen + 1u) * nloc) {
            __builtin_amdgcn_fence(__ATOMIC_RELEASE, "agent");
            asm volatile("s_waitcnt vmcnt(0)" ::: "memory");
            const unsigned og = xb_add(&bar[XB_TOP], 1u);
            const unsigned tg = og / nx;
            if (og + 1u == (tg + 1u) * nx) xb_add(&bar[XB_TOPGEN], 1u);
            else XB_SPIN(xb_ld(&bar[XB_TOPGEN]) == tg, bar);
            __builtin_amdgcn_fence(__ATOMIC_ACQUIRE, "agent");
            xb_add(&bar[XB_XGEN(b.x)], 1u);
            asm volatile("s_waitcnt vmcnt(0)" ::: "memory");
        } else {
            XB_SPIN(xb_ld(&bar[XB_XGEN(b.x)]) == gen, bar);
            __builtin_amdgcn_fence(__ATOMIC_ACQUIRE, "agent");
            asm volatile("s_waitcnt vmcnt(0)" ::: "memory");
        }
    }
    __syncthreads();
}

namespace mk {
typedef unsigned short bf16;
typedef unsigned v4u __attribute__((ext_vector_type(4)));
typedef unsigned v2u __attribute__((ext_vector_type(2)));
typedef float f32x4 __attribute__((ext_vector_type(4)));
typedef float f32x2 __attribute__((ext_vector_type(2)));

constexpr int S = 8192, D = 2048, NL = 4, NADA = 6 * D;
constexpr int NIN = 10776, ZLD = 11008, NUP = 11264, DFF = 5632;
constexpr int ZQ = 0, ZKC = 1024, ZVC = 1280, ZKS = 1536, ZVS = 1792, ZKW = 2048, ZVW = 2304, ZAG = 2560, ZQH = 2584, ZFH = 3608, ZIH = 4632, ZOG = 5656, ZMG = 6680;
constexpr int NCMP = 511, NSEL = 128, TOPK = 16, WINDOW = 512;
constexpr int HGC = 64, HGNC = S / HGC;
constexpr float EPS = 1e-6f;
constexpr float QSCALE = 0.08838834764831845f;
constexpr int KSPLIT = 8;

constexpr size_t MiB = 1u << 20;
constexpr size_t WS_CTL = 0, CTL_ZERO_BYTES = 64 * 1024;
constexpr size_t WS_ADAP = 1 * MiB;
constexpr size_t WS_ADA = 3 * MiB;
constexpr size_t WS_LB = 3 * MiB + 256 * 1024;
constexpr size_t WS_ROPE = 4 * MiB;
constexpr size_t WS_KCMP = 8 * MiB;
constexpr size_t WS_VCMP = 8 * MiB + 512 * 1024;
constexpr size_t WS_SELM = 10 * MiB;
constexpr size_t WS_HGD = 9 * MiB;
constexpr size_t WS_WIN = 16 * MiB;
constexpr size_t WS_WUP = 188 * MiB;
constexpr size_t WS_WDN = 364 * MiB;
constexpr size_t WS_WOUT = 452 * MiB;
constexpr size_t WS_WBA = 484 * MiB;
constexpr size_t WS_WBH = 500 * MiB;
constexpr size_t WS_H = 516 * MiB;
constexpr size_t WS_Z = 548 * MiB;
constexpr size_t WS_ATTN = 724 * MiB;
constexpr size_t WS_HG = 740 * MiB;
constexpr size_t WS_PART = 756 * MiB;
constexpr size_t WS_MIXED = 820 * MiB;
constexpr size_t WS_Y = 852 * MiB;
constexpr size_t WS_G = 916 * MiB;
constexpr size_t WS_HGS = 1004 * MiB;
constexpr size_t WS_WKC = 1068 * MiB;
constexpr size_t WS_WVC = 1072 * MiB;
constexpr size_t WS_PEBP = 1076 * MiB;
constexpr size_t WS_PEB = 1076 * MiB + 256 * 1024;
constexpr size_t WS_H2 = 1077 * MiB;
constexpr size_t WS_KVC = 1112 * MiB;
constexpr size_t WS_QR = 1128 * MiB;
constexpr size_t WS_KCR = 1144 * MiB;
constexpr size_t WS_HGS2 = 1148 * MiB;
constexpr size_t WS_END = 1212 * MiB;
constexpr int CW_BAR = 4096;

constexpr int RING_BYTES = 131072, LDS_BYTES = 155648, LDSCTL_OFF = LDS_BYTES - 512;

#ifndef REP_SELB
#define REP_SELB 1
#endif
#ifndef G2_ALIGN
#define G2_ALIGN true
#endif
#ifndef G2_SP2
#define G2_SP2 true
#endif
#ifndef GEMM_V2
#define GEMM_V2 1
#endif
#ifndef REP_BAR
#define REP_BAR 1
#endif
#ifndef DEFER_THR
#define DEFER_THR 8.0f
#endif
#ifndef REP_CMPB
#define REP_CMPB 1
#endif
#ifndef REP_WINB
#define REP_WINB 1
#endif
#ifndef REP_GZ
#define REP_GZ 1
#endif
#ifndef REP_GF
#define REP_GF 1
#endif
#ifndef REP_GG
#define REP_GG 1
#endif
#ifndef REP_GU
#define REP_GU 1
#endif
#ifndef REP_GD
#define REP_GD 1
#endif
#ifndef SEL_SPLIT
#define SEL_SPLIT 1
#endif
#ifndef HALF_PRIO
#define HALF_PRIO 0
#endif
#ifndef SEL_SKIP
#define SEL_SKIP 1
#endif
#ifndef DMA_LATE
#define DMA_LATE 0
#endif
#ifndef REP_QK
#define REP_QK 1
#endif
#ifndef SEL_PVF
#define SEL_PVF false
#endif
#ifndef WIN_PVF
#define WIN_PVF false
#endif
#ifndef PVF_EARLYV
#define PVF_EARLYV 0
#endif
#ifndef SEL_PVF2
#define SEL_PVF2 false
#endif
#ifndef QK_DB
#define QK_DB 0
#endif
#ifndef HG_DYN
#define HG_DYN 1
#endif
#ifndef NGZ
#define NGZ 256
#endif
#ifndef RES_BF16
#define RES_BF16 0
#endif
#ifndef ROW_NR
#define ROW_NR 4
#endif
#ifndef BR_CARRY
#define BR_CARRY 1
#endif
#ifndef IDLE_MUL
#define IDLE_MUL 1
#endif
#ifndef HALF_PRIO_WHO
#define HALF_PRIO_WHO 1
#endif
#ifndef REP_TOPK
#define REP_TOPK 1
#endif
#ifndef TOPK_RADIX
#define TOPK_RADIX 1
#endif
#ifndef PV_DB
#define PV_DB 1
#endif
#ifndef REP_ROPE
#define REP_ROPE 1
#endif
#ifndef REP_P2
#define REP_P2 1
#endif
#ifndef REP_ROWPRE
#define REP_ROWPRE 0
#endif
#ifndef REP_P0
#define REP_P0 1
#endif
#ifndef REP_CMPR
#define REP_CMPR 1
#endif
#ifndef REP_P1
#define REP_P1 1
#endif
#ifndef REP_CONV
#define REP_CONV 1
#endif
#define LDS_WAIT() asm volatile("s_waitcnt lgkmcnt(0)" ::: "memory")

__device__ __forceinline__ float bf2f(unsigned v) { return __uint_as_float(v << 16); }
__device__ __forceinline__ float bflo(unsigned w) { return __uint_as_float(w << 16); }
__device__ __forceinline__ float bfhi(unsigned w) { return __uint_as_float(w & 0xffff0000u); }
typedef __bf16 bf16x2_t __attribute__((ext_vector_type(2)));
__device__ __forceinline__ unsigned pk2(float lo, float hi) { const f32x2 v = {lo, hi}; return __builtin_bit_cast(unsigned, __builtin_convertvector(v, bf16x2_t)); }
__device__ __forceinline__ unsigned f2bf(float f) { return pk2(f, 0.f) & 0xffffu; }
__device__ __forceinline__ float wave_sum(float v) {
#pragma unroll
    for (int o = 1; o < 64; o <<= 1) v += __shfl_xor(v, o);
    return v;
}
__device__ __forceinline__ float wave_max(float v) {
#pragma unroll
    for (int o = 1; o < 64; o <<= 1) v = fmaxf(v, __shfl_xor(v, o));
    return v;
}
__device__ __forceinline__ float sigmoidf_(float x) { return __builtin_amdgcn_rcpf(1.0f + __expf(-x)); }
__device__ __forceinline__ float siluf_(float x) { return x * __builtin_amdgcn_rcpf(1.0f + __expf(-x)); }

struct Args { const float* in[23]; float* out; unsigned char* ws; int ph_lo, ph_hi; };

struct Frame {
    LAS unsigned char* lds;
    int tid, lane, wave, G, bid;
    unsigned char* ws;
    float* out;
};
__device__ __forceinline__ const float* inp(const Frame& F, int k) {
    const unsigned long long v = ((const LAS unsigned long long*)(F.lds + LDSCTL_OFF + 128))[k];
    const unsigned lo = __builtin_amdgcn_readfirstlane((unsigned)v), hi = __builtin_amdgcn_readfirstlane((unsigned)(v >> 32));
    return (const float*)(((unsigned long long)hi << 32) | lo);
}

template <bool UPPERM = false>
__device__ __forceinline__ void tr_item(const float* W, int K, int N, int Npad, bf16* WT, LAS float* scr, int item, int lane) {
    const int nblk = Npad / 64, kb = item / nblk, nb = item % nblk, k0 = 64 * kb, n0 = 64 * nb;
    const int ns0 = UPPERM ? ((n0 & 255) >> 7) * DFF + (n0 >> 8) * 128 + (n0 & 127) : n0;
    const int kq = lane >> 4, n4 = 4 * (lane & 15);
    const bool ok = ns0 + n4 < N;
    f32x4 tv[16];
#pragma unroll
    for (int i = 0; i < 16; ++i) tv[i] = ok ? *(const f32x4*)(W + (size_t)(k0 + 4 * i + kq) * N + ns0 + n4) : (f32x4){0.f, 0.f, 0.f, 0.f};
#pragma unroll
    for (int i = 0; i < 16; ++i) { LAS float* d = scr + (4 * i + kq) * 65 + n4; d[0] = tv[i].x; d[1] = tv[i].y; d[2] = tv[i].z; d[3] = tv[i].w; }
    LDS_WAIT(); asm volatile("" ::: "memory");
    const int c = lane & 7;
#pragma unroll
    for (int j = 0; j < 8; ++j) { const int n = (lane >> 3) + 8 * j; const LAS float* sp = scr + (8 * c) * 65 + n;
        v4u o; o.x = pk2(sp[0 * 65], sp[1 * 65]); o.y = pk2(sp[2 * 65], sp[3 * 65]); o.z = pk2(sp[4 * 65], sp[5 * 65]); o.w = pk2(sp[6 * 65], sp[7 * 65]);
        *(v4u*)(WT + (size_t)(n0 + n) * K + k0 + 8 * c) = o; }
    LDS_WAIT(); asm volatile("" ::: "memory");
}

constexpr int I_IN = (D / 64) * (ZLD / 64), I_UP = (D / 64) * (NUP / 64), I_DN = (DFF / 64) * (D / 64), I_OUT = (D / 64) * (D / 64), I_BR = (1024 / 64) * (D / 64), I_CW = (4096 / 64) * (128 / 64);
constexpr int I_LAYER = I_IN + I_UP + I_DN + I_OUT + 2 * I_BR + 2 * I_CW;
#ifndef CONV_AHEAD
#define CONV_AHEAD 1
#endif
__device__ __forceinline__ void conv_item(Frame& F, int l, int r, LAS float* scr) {
    if (r < I_IN) { tr_item(inp(F, 6) + (size_t)l * D * NIN, D, NIN, ZLD, (bf16*)(F.ws + WS_WIN) + (size_t)l * ZLD * D, scr, r, F.lane); return; } r -= I_IN;
    if (r < I_UP) { tr_item<true>(inp(F, 18) + (size_t)l * D * NUP, D, NUP, NUP, (bf16*)(F.ws + WS_WUP) + (size_t)l * NUP * D, scr, r, F.lane); return; } r -= I_UP;
    if (r < I_DN) { tr_item(inp(F, 21) + (size_t)l * DFF * D, DFF, D, D, (bf16*)(F.ws + WS_WDN) + (size_t)l * D * DFF, scr, r, F.lane); return; } r -= I_DN;
    if (r < I_OUT) { tr_item(inp(F, 15) + (size_t)l * D * D, D, D, D, (bf16*)(F.ws + WS_WOUT) + (size_t)l * D * D, scr, r, F.lane); return; } r -= I_OUT;
    if (r < I_BR) { tr_item(inp(F, 13) + (size_t)l * 1024 * D, 1024, D, D, (bf16*)(F.ws + WS_WBA) + (size_t)l * 2 * D * 1024, scr, r, F.lane); return; } r -= I_BR;
    if (r < I_BR) { tr_item(inp(F, 14) + (size_t)l * 1024 * D, 1024, D, D, (bf16*)(F.ws + WS_WBA) + (size_t)(l * 2 + 1) * D * 1024, scr, r, F.lane); return; } r -= I_BR;
    if (r < I_CW) { tr_item(inp(F, 8) + (size_t)l * 4096 * 128, 4096, 128, 128, (bf16*)(F.ws + WS_WKC) + (size_t)l * 128 * 4096, scr, r, F.lane); return; } r -= I_CW;
    tr_item(inp(F, 10) + (size_t)l * 4096 * 128, 4096, 128, 128, (bf16*)(F.ws + WS_WVC) + (size_t)l * 128 * 4096, scr, r, F.lane);
}
__device__ __forceinline__ void convert_queue(Frame& F, int l) {
    unsigned* qw = (unsigned*)(F.ws + WS_CTL) + 2048 + 64 * l;
    LAS unsigned* slot = (LAS unsigned*)(F.lds + LDSCTL_OFF + 64);
    LAS float* scr = (LAS float*)(F.lds + F.wave * 17408);
    for (;;) {
        if (F.tid == 0) *slot = __hip_atomic_fetch_add(qw, 32u, __ATOMIC_RELAXED, __HIP_MEMORY_SCOPE_AGENT);
        __syncthreads();
        const unsigned base = *slot;
        __syncthreads();
        if (base >= (unsigned)I_LAYER) break;
#pragma unroll 1
        for (int i = 0; i < 4; ++i) { const int r = (int)base + i * 8 + F.wave; if (r < I_LAYER) conv_item(F, l, r, scr); }
    }
}
__device__ __forceinline__ void p0_prologue(Frame& F) {
    const int gtid = F.bid * 512 + F.tid, NT = F.G * 512;
    {
        LAS float* cact = (LAS float*)F.lds;
        for (int k = F.tid; k < D; k += 512) cact[k] = siluf_(inp(F, 1)[k]);
        __syncthreads();
        const float* w_ada = inp(F, 3);
        float* part = (float*)(F.ws + WS_ADAP);
        for (int idx = gtid; idx < KSPLIT * NL * (NADA / 4); idx += NT) {
            const int ks = idx / (NL * (NADA / 4)), rem = idx % (NL * (NADA / 4)), l = rem / (NADA / 4), col = 4 * (rem % (NADA / 4));
            const float* wp = w_ada + ((size_t)l * D + (size_t)ks * (D / KSPLIT)) * NADA + col;
            f32x4 acc = {0.f, 0.f, 0.f, 0.f};
#pragma unroll 16
            for (int k = 0; k < D / KSPLIT; ++k) { const f32x4 w = *(const f32x4*)(wp + (size_t)k * NADA); acc += w * cact[ks * (D / KSPLIT) + k]; }
            *(f32x4*)(part + (size_t)(ks * NL + l) * NADA + col) = acc;
        }
        __syncthreads();
    }
    {
        float* ct = (float*)(F.ws + WS_ROPE); float* st = ct + (size_t)S * 64;
        const int* pos = (const int*)inp(F, 2);
        for (int idx = gtid; idx < S * 64; idx += NT) {
            const int t = idx >> 6, i = idx & 63;
            const float invf = 1.0f / __builtin_powf(10000.0f, (float)(2 * i) / 128.0f);
            const float angf = (float)pos[t] * invf;
            const double a = (double)angf;
            const double q = __builtin_rint(a * 0.63661977236758134308);
            const double r = (a - q * 1.57079632679489655800) - q * 6.12323399573676603587e-17;
            const double r2 = r * r;
            double sp = -2.50521083854417187751e-08; sp = sp * r2 + 2.75573192239858906526e-06; sp = sp * r2 - 1.98412698412698412698e-04; sp = sp * r2 + 8.33333333333333333333e-03; sp = sp * r2 - 1.66666666666666666667e-01;
            const double sr = r + r * r2 * sp;
            double cp = 2.08767569878680989792e-09; cp = cp * r2 - 2.75573192239858906526e-07; cp = cp * r2 + 2.48015873015873015873e-05; cp = cp * r2 - 1.38888888888888888889e-03; cp = cp * r2 + 4.16666666666666666667e-02; cp = cp * r2 - 0.5;
            const double cr = 1.0 + r2 * cp;
            const int qi = ((int)(long long)q) & 3;
            const double sv = (qi == 0) ? sr : (qi == 1) ? cr : (qi == 2) ? -sr : -cr;
            const double cv = (qi == 0) ? cr : (qi == 1) ? -sr : (qi == 2) ? -cr : sr;
            ct[idx] = (float)cv; st[idx] = (float)sv;
        }
    }
    for (int i = gtid; i < 2 * D / 8; i += NT) ((v4u*)(F.ws + WS_H2))[i] = (v4u){0u, 0u, 0u, 0u};
    {
        float* lb = (float*)(F.ws + WS_LB); const float* lg = inp(F, 11);
        for (int c = gtid; c < 1024; c += NT) {
            float v[NL], m = -1e30f;
#pragma unroll
            for (int l = 0; l < NL; ++l) { v[l] = lg[l * 1024 + c]; m = fmaxf(m, v[l]); }
            float s = 0.f;
#pragma unroll
            for (int l = 0; l < NL; ++l) { v[l] = expf(v[l] - m); s += v[l]; }
            float run = 0.f;
#pragma unroll
            for (int l = 0; l < NL; ++l) { lb[l * 1024 + c] = run; if (l + 1 < NL) run += v[l + 1] / s; }
        }
    }
    {
        LAS float* scr = (LAS float*)(F.lds + 8192 + F.wave * 17408);
        const int gw = F.bid * 8 + F.wave, NGW = F.G * 8;
        for (int it = gw; it < (CONV_AHEAD ? 1 : NL) * I_LAYER; it += NGW) conv_item(F, it / I_LAYER, it % I_LAYER, scr);
    }
    {
        const int gtid = F.bid * 512 + F.tid, NT = F.G * 512;
        for (int idx = gtid; idx < NL * 2 * 32 * 128; idx += NT) {
            const int j = idx & 127, ks = (idx >> 7) & 31, lk = idx >> 12, l = lk >> 1, kv = lk & 1;
            const float* pe = (kv ? inp(F, 9) : inp(F, 7)) + (size_t)l * 4096 + ks * 128;
            const float* w = (kv ? inp(F, 10) : inp(F, 8)) + ((size_t)l * 4096 + ks * 128) * 128 + j;
            float acc = 0.f;
#pragma unroll 8
            for (int k = 0; k < 128; ++k) acc += pe[k] * w[(size_t)k * 128];
            ((float*)(F.ws + WS_PEBP))[idx] = acc;
        }
    }
}
__device__ __forceinline__ void p0b_ada(Frame& F) {
    const int gtid = F.bid * 512 + F.tid, NT = F.G * 512;
    const float* part = (const float*)(F.ws + WS_ADAP); float* ada = (float*)(F.ws + WS_ADA);
    for (int j = gtid; j < NL * NADA; j += NT) { float s = inp(F, 4)[j];
#pragma unroll
        for (int ks = 0; ks < KSPLIT; ++ks) s += part[(size_t)ks * NL * NADA + j];
        ada[j] = s; }
    for (int i = gtid; i < NL * 2 * 128; i += NT) { const int j = i & 127, lk = i >> 7; float s = 0.f;
        for (int ks = 0; ks < 32; ++ks) s += ((const float*)(F.ws + WS_PEBP))[(lk * 32 + ks) * 128 + j];
        ((float*)(F.ws + WS_PEB))[i] = s; }
}

template <bool POST, bool PRE, bool XIB = false, bool XOB = false>
__device__ __forceinline__ void row_phase(Frame& F, const void* xin_, const bf16* y, void* xout_, bf16* h,
                                          const float* gpost, const float* gt, const float* gpre, const float* sc, const float* sh) {
    const float* xin = (const float*)xin_; const bf16* xinb = (const bf16*)xin_; float* xout = (float*)xout_; bf16* xoutb = (bf16*)xout_;
    const int gw = F.bid * 8 + F.wave, NGW = F.G * 8, lane = F.lane;
    f32x4 xa[8], xb[8]; v2u ya[8], yb[8];
#define RP_LOAD(X_, Y_, r_) do { _Pragma("unroll") for (int j = 0; j < 8; ++j) { \
        if (XIB) { const v2u a_ = *(const v2u*)(xinb + (size_t)(r_) * D + 4 * lane + 256 * j); X_[j] = (f32x4){bflo(a_.x), bfhi(a_.x), bflo(a_.y), bfhi(a_.y)}; } \
        else X_[j] = *(const f32x4*)(xin + (size_t)(r_) * D + 4 * lane + 256 * j); \
        if (POST) Y_[j] = *(const v2u*)(y + (size_t)(r_) * D + 4 * lane + 256 * j); } } while (0)
#define RP_PROC(X_, Y_, row) do { \
        f32x4 x[8]; \
        _Pragma("unroll") for (int j = 0; j < 8; ++j) x[j] = X_[j]; \
        if (POST) { \
            f32x4 yv[8]; float ss = 0.f; \
            _Pragma("unroll") for (int j = 0; j < 8; ++j) { const v2u yw = Y_[j]; yv[j] = (f32x4){bflo(yw.x), bfhi(yw.x), bflo(yw.y), bfhi(yw.y)}; \
                ss += (yv[j].x * yv[j].x + yv[j].y * yv[j].y) + (yv[j].z * yv[j].z + yv[j].w * yv[j].w); } \
            const float r1s = 1.0f / sqrtf(wave_sum(ss) * (1.0f / D) + EPS); \
            _Pragma("unroll") for (int j = 0; j < 8; ++j) { const f32x4 g = *(const f32x4*)(gpost + 4 * lane + 256 * j), a = *(const f32x4*)(gt + 4 * lane + 256 * j); \
                x[j] = x[j] + a * ((yv[j] * r1s) * g); \
                if (XOB) { v2u w; w.x = pk2(x[j].x, x[j].y); w.y = pk2(x[j].z, x[j].w); *(v2u*)(xoutb + (size_t)(row) * D + 4 * lane + 256 * j) = w; } \
                else *(f32x4*)(xout + (size_t)(row) * D + 4 * lane + 256 * j) = x[j]; } \
        } \
        if (PRE) { \
            float ss = 0.f; \
            _Pragma("unroll") for (int j = 0; j < 8; ++j) ss += (x[j].x * x[j].x + x[j].y * x[j].y) + (x[j].z * x[j].z + x[j].w * x[j].w); \
            const float r2 = 1.0f / sqrtf(wave_sum(ss) * (1.0f / D) + EPS); \
            _Pragma("unroll") for (int j = 0; j < 8; ++j) { const f32x4 g = *(const f32x4*)(gpre + 4 * lane + 256 * j), a = *(const f32x4*)(sc + 4 * lane + 256 * j), b = *(const f32x4*)(sh + 4 * lane + 256 * j); \
                const f32x4 o = ((x[j] * r2) * g) * (a + 1.0f) + b; \
                v2u w; w.x = pk2(o.x, o.y); w.y = pk2(o.z, o.w); \
                *(v2u*)(h + (size_t)(row) * D + 4 * lane + 256 * j) = w; } \
        } } while (0)
    if (gw < S) RP_LOAD(xa, ya, gw);
    if (gw + NGW < S) RP_LOAD(xb, yb, gw + NGW);
    for (int row0 = gw; row0 < S; row0 += 2 * NGW) {
        RP_PROC(xa, ya, row0);
        if (row0 + 2 * NGW < S) RP_LOAD(xa, ya, row0 + 2 * NGW);
        if (row0 + NGW < S) {
            RP_PROC(xb, yb, row0 + NGW);
            if (row0 + 3 * NGW < S) RP_LOAD(xb, yb, row0 + 3 * NGW);
        }
    }
#undef RP_PROC
#undef RP_LOAD
}

__device__ __forceinline__ void phase_c(Frame& F, int l) {
    const int gtid = F.bid * 512 + F.tid, NT = F.G * 512, lane = F.lane;
    bf16* z = (bf16*)(F.ws + WS_Z);
    const float* ct = (const float*)(F.ws + WS_ROPE); const float* st = ct + (size_t)S * 64;
    for (int rep_ = 0; rep_ < REP_ROPE; ++rep_)
    for (int idx = gtid; idx < S * 112; idx += NT) {
        const int t = idx / 112, r = idx % 112, hd = r >> 3, ch = r & 7;
        const int col = hd < 8 ? ZQ + hd * 128 : (hd < 10 ? ZKS + (hd - 8) * 128 : (hd < 12 ? ZKW + (hd - 10) * 128 : ZKC + (hd - 12) * 128));
        bf16* p1 = z + (size_t)t * ZLD + col + 8 * ch; bf16* p2 = p1 + 64;
        const v4u a = *(const v4u*)p1, b = *(const v4u*)p2;
        const f32x4 c0 = *(const f32x4*)(ct + (size_t)t * 64 + 8 * ch), c1 = *(const f32x4*)(ct + (size_t)t * 64 + 8 * ch + 4);
        const f32x4 s0 = *(const f32x4*)(st + (size_t)t * 64 + 8 * ch), s1 = *(const f32x4*)(st + (size_t)t * 64 + 8 * ch + 4);
        v4u oa, ob;
        const float cs8[8] = {c0.x, c0.y, c0.z, c0.w, c1.x, c1.y, c1.z, c1.w}, sn8[8] = {s0.x, s0.y, s0.z, s0.w, s1.x, s1.y, s1.z, s1.w};
#pragma unroll
        for (int e = 0; e < 4; ++e) {
            const float x1l = bflo(a[e]), x1h = bfhi(a[e]), x2l = bflo(b[e]), x2h = bfhi(b[e]);
            const float cl = cs8[2 * e], chh = cs8[2 * e + 1], sl = sn8[2 * e], shh = sn8[2 * e + 1];
            oa[e] = pk2(x1l * cl - x2l * sl, x1h * chh - x2h * shh);
            ob[e] = pk2(x2l * cl + x1l * sl, x2h * chh + x1h * shh);
        }
        if (hd >= 8 && hd < 12) {
            bf16* o = (bf16*)(F.ws + WS_KVC) + ((size_t)((hd < 10 ? 0 : 2) * 2 + (hd & 1)) * S + t) * 128 + 8 * ch;
            *(v4u*)o = oa; *(v4u*)(o + 64) = ob;
        } else if (hd < 8) { bf16* o = (bf16*)(F.ws + WS_QR) + (size_t)t * 1024 + hd * 128 + 8 * ch; *(v4u*)o = oa; *(v4u*)(o + 64) = ob; }
        else { bf16* o = (bf16*)(F.ws + WS_KCR) + (size_t)t * 256 + (hd - 12) * 128 + 8 * ch; *(v4u*)o = oa; *(v4u*)(o + 64) = ob; }
    }
    for (int rep_ = 0; rep_ < REP_ROPE; ++rep_)
    for (int idx = gtid; idx < S * 64; idx += NT) {
        const int t = idx >> 6, r = idx & 63, which = r >> 4, ch = r & 15;
        const v4u v = *(const v4u*)(z + (size_t)t * ZLD + (which < 2 ? ZVS : ZVW) + (which & 1) * 128 + 8 * ch);
        *(v4u*)((bf16*)(F.ws + WS_KVC) + ((size_t)((which < 2 ? 1 : 3) * 2 + (which & 1)) * S + t) * 128 + 8 * ch) = v;
    }
}

__device__ __forceinline__ void compress_mfma(Frame& F, int l) {
    typedef short bf16x8 __attribute__((ext_vector_type(8)));
    const int lane = F.lane, w = F.wave, fr = lane & 15, fq = lane >> 4;
    const bf16* z = (const bf16*)(F.ws + WS_Z);
    LAS float* red = (LAS float*)F.lds;
    for (int it = F.bid; it < 64 * 4; it += F.G) {
        const int rt = it >> 2, kv = (it >> 1) & 1, nh = it & 1;
        const int r = 16 * rt + fr; int n = r >> 1; const int g = r & 1; if (n > NCMP - 1) n = NCMP - 1;
        const bf16* arow = kv ? z + (size_t)(16 * n) * ZLD + ZVC + g * 128 : (const bf16*)(F.ws + WS_KCR) + (size_t)(16 * n) * 256 + g * 128;
        const size_t apitch = kv ? (size_t)ZLD : (size_t)256;
        const bf16* wt = (const bf16*)(F.ws + (kv ? WS_WVC : WS_WKC)) + (size_t)l * 128 * 4096 + (size_t)(64 * nh) * 4096;
        pg8::f32x4 acc[4];
#pragma unroll
        for (int nt = 0; nt < 4; ++nt) acc[nt] = (pg8::f32x4){0.f, 0.f, 0.f, 0.f};
#pragma unroll 4
        for (int ks = 0; ks < 16; ++ks) {
            const int k0 = 32 * (16 * w + ks) + 8 * fq, pp = k0 >> 7, d = k0 & 127;
            const bf16x8 af = *(const bf16x8*)(arow + (size_t)pp * apitch + d);
#pragma unroll
            for (int nt = 0; nt < 4; ++nt) { const bf16x8 bfg = *(const bf16x8*)(wt + (size_t)(16 * nt + fr) * 4096 + k0);
                acc[nt] = __builtin_amdgcn_mfma_f32_16x16x32_bf16(af, bfg, acc[nt], 0, 0, 0); }
        }
#pragma unroll
        for (int nt = 0; nt < 4; ++nt)
#pragma unroll
            for (int e = 0; e < 4; ++e) red[(w * 16 + 4 * fq + e) * 64 + 16 * nt + fr] = acc[nt][e];
        __syncthreads();
        { const float* peb = (const float*)(F.ws + WS_PEB) + (l * 2 + kv) * 128 + 64 * nh;
          bf16* o = (bf16*)(F.ws + (kv ? WS_VCMP : WS_KCMP)) + 64 * nh;
          const int row = F.tid >> 5, c2 = (F.tid & 31) * 2;
          float s0 = peb[c2], s1 = peb[c2 + 1];
#pragma unroll
          for (int ww = 0; ww < 8; ++ww) { s0 += red[(ww * 16 + row) * 64 + c2]; s1 += red[(ww * 16 + row) * 64 + c2 + 1]; }
          const int rr = 16 * rt + row;
          *(unsigned*)(o + (size_t)rr * 128 + c2) = rr < NCMP * 2 ? pk2(s0, s1) : 0u; }
        __syncthreads();
    }
}

__device__ __forceinline__ void hgrn_pass2(Frame& F) {
    const int gtid = F.bid * 512 + F.tid, NT = F.G * 512;
    const unsigned* hgS = (const unsigned*)(F.ws + WS_HGS); unsigned* hgS2 = (unsigned*)(F.ws + WS_HGS2); const float* hgD = (const float*)(F.ws + WS_HGD);
    for (int e2 = gtid; e2 < 8 * 128 * 64; e2 += NT) {
        const int e = 2 * e2, hd = ((e >> 14) << 7) | (e & 127);
        float st0 = 0.f, st1 = 0.f;
        for (int c0 = 0; c0 < HGNC; c0 += 16) {
            unsigned u[16]; f32x2 dc[16];
#pragma unroll
            for (int i = 0; i < 16; ++i) { u[i] = hgS[(size_t)(c0 + i) * 65536 + e2]; dc[i] = *(const f32x2*)(hgD + (size_t)(c0 + i) * 1024 + hd); }
#pragma unroll
            for (int i = 0; i < 16; ++i) { hgS2[(size_t)(c0 + i) * 65536 + e2] = pk2(st0, st1); st0 = dc[i].x * st0 + bflo(u[i]); st1 = dc[i].y * st1 + bfhi(u[i]); }
        }
    }
}

namespace fa {
typedef short bf16x8 __attribute__((ext_vector_type(8)));
typedef short s16x4 __attribute__((ext_vector_type(4)));
typedef float f32x16 __attribute__((ext_vector_type(16)));
constexpr int SHM_T = 64 * 128 * 2;
constexpr float C2 = 1.4426950408889634f * QSCALE;
#define FA_KSWZ(row, colB) ((row) * 256 + ((colB) ^ (((row) & 7) << 4)))
__device__ __forceinline__ int v_st(int k, int c) { const int kk = (k & ~0xC) | ((k & 4) << 1) | ((k & 8) >> 1); return ((kk >> 3) * 4 + (c >> 5)) * 512 + ((kk & 7) * 32 + (c & 31)) * 2; }
__device__ __forceinline__ int v_rd_base(int lane) { return ((lane & 3) << 3) | (((lane >> 2) & 3) << 6) | (((lane >> 4) & 1) << 5) | (((lane >> 5) & 1) << 8); }
constexpr int v_rd_off(int d0, int ks, int half) { return d0 * 512 + ks * 4096 + half * 2048; }
__device__ __forceinline__ int crow(int r, int hi) { return (r & 3) + 8 * (r >> 2) + 4 * hi; }
__device__ __forceinline__ unsigned cvtpk(float lo, float hi) { return pk2(lo, hi); }
__device__ __forceinline__ void qkt(f32x16& p0, f32x16& p1, const LAS char* K_t, int r32, int hi, const bf16x8* qr) {
    p0 = f32x16{}; p1 = f32x16{};
    const LAS char* kb[4];
#pragma unroll
    for (int dd = 0; dd < 4; ++dd) kb[dd] = K_t + FA_KSWZ(r32, (dd * 16 + hi * 8) * 2);
#pragma unroll
    for (int d0 = 0; d0 < 8; ++d0) { const LAS char* a = kb[d0 & 3] + (d0 >> 2) * 128;
        const bf16x8 b0 = *reinterpret_cast<const LAS bf16x8*>(a);
        const bf16x8 b1 = *reinterpret_cast<const LAS bf16x8*>(a + 32 * 256);
        p0 = __builtin_amdgcn_mfma_f32_32x32x16_bf16(b0, qr[d0], p0, 0, 0, 0);
        p1 = __builtin_amdgcn_mfma_f32_32x32x16_bf16(b1, qr[d0], p1, 0, 0, 0); }
}
__device__ __forceinline__ void qkt_db(f32x16& p0, f32x16& p1, const LAS char* K_t, int r32, int hi, const bf16x8* qr) {
    p0 = f32x16{}; p1 = f32x16{};
    int ka[4];
#pragma unroll
    for (int dd = 0; dd < 4; ++dd) ka[dd] = (int)(unsigned)(size_t)(K_t + FA_KSWZ(r32, (dd * 16 + hi * 8) * 2));
#define FA_KRD(dst, a, off) asm volatile("ds_read_b128 %0, %1 offset:%2" : "=&v"(dst) : "v"(a), "i"(off) : "memory")
#define FA_KW(n, x, y) asm volatile("s_waitcnt lgkmcnt(" #n ")" : "+v"(x), "+v"(y) :: "memory")
#define FA_KMM(x, y, d0) do { p0 = __builtin_amdgcn_mfma_f32_32x32x16_bf16(x, qr[d0], p0, 0, 0, 0); p1 = __builtin_amdgcn_mfma_f32_32x32x16_bf16(y, qr[d0], p1, 0, 0, 0); } while (0)
    bf16x8 a0, a1, b0, b1;
    FA_KRD(a0, ka[0], 0); FA_KRD(a1, ka[0], 8192); FA_KRD(b0, ka[1], 0); FA_KRD(b1, ka[1], 8192);
    FA_KW(2, a0, a1); FA_KMM(a0, a1, 0); FA_KRD(a0, ka[2], 0); FA_KRD(a1, ka[2], 8192);
    FA_KW(2, b0, b1); FA_KMM(b0, b1, 1); FA_KRD(b0, ka[3], 0); FA_KRD(b1, ka[3], 8192);
    FA_KW(2, a0, a1); FA_KMM(a0, a1, 2); FA_KRD(a0, ka[0], 128); FA_KRD(a1, ka[0], 8320);
    FA_KW(2, b0, b1); FA_KMM(b0, b1, 3); FA_KRD(b0, ka[1], 128); FA_KRD(b1, ka[1], 8320);
    FA_KW(2, a0, a1); FA_KMM(a0, a1, 4); FA_KRD(a0, ka[2], 128); FA_KRD(a1, ka[2], 8320);
    FA_KW(2, b0, b1); FA_KMM(b0, b1, 5); FA_KRD(b0, ka[3], 128); FA_KRD(b1, ka[3], 8320);
    FA_KW(2, a0, a1); FA_KMM(a0, a1, 6);
    FA_KW(0, b0, b1); FA_KMM(b0, b1, 7);
#undef FA_KMM
#undef FA_KW
#undef FA_KRD
}
__device__ __forceinline__ void pv_tile(f32x16* o, int vb0, bf16x8 pa0, bf16x8 pa1, bf16x8 pa2, bf16x8 pa3) {
#define FA_TRRD(dst, off) asm volatile("ds_read_b64_tr_b16 %0, %1 offset:%2" : "=&v"(dst) : "v"(vb0), "i"(off) : "memory")
#define FA_PV_D0(d0) do { s16x4 l0, l1, l2, l3, h0, h1, h2, h3; constexpr int b_ = v_rd_off(d0, 0, 0); \
        FA_TRRD(l0, b_); FA_TRRD(h0, b_ + 2048); FA_TRRD(l1, b_ + 4096); FA_TRRD(h1, b_ + 6144); FA_TRRD(l2, b_ + 8192); FA_TRRD(h2, b_ + 10240); FA_TRRD(l3, b_ + 12288); FA_TRRD(h3, b_ + 14336); \
        asm volatile("s_waitcnt lgkmcnt(0)" ::: "memory"); __builtin_amdgcn_sched_barrier(0); \
        o[d0] = __builtin_amdgcn_mfma_f32_32x32x16_bf16(pa0, (bf16x8){l0[0], l0[1], l0[2], l0[3], h0[0], h0[1], h0[2], h0[3]}, o[d0], 0, 0, 0); \
        o[d0] = __builtin_amdgcn_mfma_f32_32x32x16_bf16(pa1, (bf16x8){l1[0], l1[1], l1[2], l1[3], h1[0], h1[1], h1[2], h1[3]}, o[d0], 0, 0, 0); \
        o[d0] = __builtin_amdgcn_mfma_f32_32x32x16_bf16(pa2, (bf16x8){l2[0], l2[1], l2[2], l2[3], h2[0], h2[1], h2[2], h2[3]}, o[d0], 0, 0, 0); \
        o[d0] = __builtin_amdgcn_mfma_f32_32x32x16_bf16(pa3, (bf16x8){l3[0], l3[1], l3[2], l3[3], h3[0], h3[1], h3[2], h3[3]}, o[d0], 0, 0, 0); } while (0)
    FA_PV_D0(0); FA_PV_D0(1); FA_PV_D0(2); FA_PV_D0(3);
#undef FA_PV_D0
#undef FA_TRRD
}
struct VSet { s16x4 l0, l1, l2, l3, h0, h1, h2, h3; };
template <int D0> __device__ __forceinline__ void v_issue(VSet& s, int vb0) {
#define FA_TRRD(dst, off) asm volatile("ds_read_b64_tr_b16 %0, %1 offset:%2" : "=&v"(dst) : "v"(vb0), "i"(off) : "memory")
    constexpr int b_ = v_rd_off(D0, 0, 0);
    FA_TRRD(s.l0, b_); FA_TRRD(s.h0, b_ + 2048); FA_TRRD(s.l1, b_ + 4096); FA_TRRD(s.h1, b_ + 6144); FA_TRRD(s.l2, b_ + 8192); FA_TRRD(s.h2, b_ + 10240); FA_TRRD(s.l3, b_ + 12288); FA_TRRD(s.h3, b_ + 14336);
#undef FA_TRRD
}
__device__ __forceinline__ void pv_mma(f32x16& o, const VSet& s, bf16x8 pa0, bf16x8 pa1, bf16x8 pa2, bf16x8 pa3) {
    o = __builtin_amdgcn_mfma_f32_32x32x16_bf16(pa0, (bf16x8){s.l0[0], s.l0[1], s.l0[2], s.l0[3], s.h0[0], s.h0[1], s.h0[2], s.h0[3]}, o, 0, 0, 0);
    o = __builtin_amdgcn_mfma_f32_32x32x16_bf16(pa1, (bf16x8){s.l1[0], s.l1[1], s.l1[2], s.l1[3], s.h1[0], s.h1[1], s.h1[2], s.h1[3]}, o, 0, 0, 0);
    o = __builtin_amdgcn_mfma_f32_32x32x16_bf16(pa2, (bf16x8){s.l2[0], s.l2[1], s.l2[2], s.l2[3], s.h2[0], s.h2[1], s.h2[2], s.h2[3]}, o, 0, 0, 0);
    o = __builtin_amdgcn_mfma_f32_32x32x16_bf16(pa3, (bf16x8){s.l3[0], s.l3[1], s.l3[2], s.l3[3], s.h3[0], s.h3[1], s.h3[2], s.h3[3]}, o, 0, 0, 0);
}
__device__ __forceinline__ void pv_tile_db(f32x16* o, int vb0, VSet& sA, bf16x8 pa0, bf16x8 pa1, bf16x8 pa2, bf16x8 pa3) {
    VSet sB;
    v_issue<1>(sB, vb0); asm volatile("s_waitcnt lgkmcnt(8)" ::: "memory"); __builtin_amdgcn_sched_barrier(0); pv_mma(o[0], sA, pa0, pa1, pa2, pa3);
    __builtin_amdgcn_sched_barrier(0);
    v_issue<2>(sA, vb0); asm volatile("s_waitcnt lgkmcnt(8)" ::: "memory"); __builtin_amdgcn_sched_barrier(0); pv_mma(o[1], sB, pa0, pa1, pa2, pa3);
    __builtin_amdgcn_sched_barrier(0);
    v_issue<3>(sB, vb0); asm volatile("s_waitcnt lgkmcnt(8)" ::: "memory"); __builtin_amdgcn_sched_barrier(0); pv_mma(o[2], sA, pa0, pa1, pa2, pa3);
    asm volatile("s_waitcnt lgkmcnt(0)" ::: "memory"); __builtin_amdgcn_sched_barrier(0); pv_mma(o[3], sB, pa0, pa1, pa2, pa3);
}
}

enum { BR_CMP2 = 0, BR_SEL = 1, BR_WIN = 2, BR_CMP1 = 3 };
struct FlashState { fa::f32x16 o[4]; float m, l; };
constexpr int FL_TAB = 8 * fa::SHM_T;
template <int MODE, bool EARLYV>
__device__ __forceinline__ void fb3_qksm(FlashState& St, const fa::bf16x8* qr, const LAS char* K_t, int vb0, fa::VSet& sA, fa::bf16x8& pa0, fa::bf16x8& pa1, fa::bf16x8& pa2, fa::bf16x8& pa3,
                                         int j, int tl, int cur, bool rowoff, LAS float* al_l, int r32, int hi, float mfix, float invl, LAS float* imp_row, LAS float* spill_row) {
    using namespace fa;
    const float NEG = -__builtin_inff();
    f32x16 p0, p1;
    if (QK_DB) qkt_db(p0, p1, K_t, r32, hi, qr); else qkt(p0, p1, K_t, r32, hi, qr);
#if REP_QK > 1
    for (int q_ = 1; q_ < REP_QK; ++q_) { asm volatile("" : "+v"(p0), "+v"(p1)); qkt(p0, p1, K_t, r32, hi, qr); }
#endif
    if (EARLYV && MODE != BR_CMP1) { __builtin_amdgcn_sched_barrier(0); v_issue<0>(sA, vb0); }
    const int kb = 64 * j;
    if (MODE == BR_WIN) {
#pragma unroll
        for (int r = 0; r < 16; ++r) { const int key = kb + (r & 3) + 8 * (r >> 2) + 4 * hi;
            if ((unsigned)(tl - key) >= (unsigned)WINDOW) p0[r] = NEG;
            if ((unsigned)(tl - key - 32) >= (unsigned)WINDOW) p1[r] = NEG; }
    } else if (MODE == BR_CMP1 || MODE == BR_CMP2) {
        const int nmax = (tl - 31) >> 4;
#pragma unroll
        for (int r = 0; r < 16; ++r) { const int key = kb + (r & 3) + 8 * (r >> 2) + 4 * hi;
            if (key > nmax) p0[r] = NEG;
            if (key + 32 > nmax) p1[r] = NEG; }
    } else {
        if (j == cur) {
#pragma unroll
            for (int r = 0; r < 16; ++r) { const int key = kb + (r & 3) + 8 * (r >> 2) + 4 * hi;
                if (key > tl) p0[r] = NEG;
                if (key + 32 > tl) p1[r] = NEG; }
        }
    }
    if (MODE == BR_CMP2) {
        const float mnL = -mfix * C2;
#pragma unroll
        for (int r = 0; r < 16; ++r) { p0[r] = __builtin_amdgcn_exp2f(fmaf(p0[r], C2, mnL)) * invl; p1[r] = __builtin_amdgcn_exp2f(fmaf(p1[r], C2, mnL)) * invl; }
        float own3[8], prt3[8];
#pragma unroll
        for (int i = 0; i < 4; ++i) { own3[i] = p0[4 * i + 3]; own3[4 + i] = p1[4 * i + 3]; }
#pragma unroll
        for (int i = 0; i < 8; ++i) { auto rr = __builtin_amdgcn_permlane32_swap(__float_as_uint(own3[i]), __float_as_uint(own3[i]), false, false); prt3[i] = __uint_as_float(hi ? rr[0] : rr[1]); }
#pragma unroll
        for (int i = 0; i < 8; ++i) {
            const float q0 = i < 4 ? p0[4 * i] : p1[4 * i - 16], q1 = i < 4 ? p0[4 * i + 1] : p1[4 * i - 15], q2 = i < 4 ? p0[4 * i + 2] : p1[4 * i - 14];
            const float prev = hi ? prt3[i] : (i > 0 ? prt3[i > 0 ? i - 1 : 0] : 0.f);
            float v = (q0 + q1) + (q2 + 0.5f * own3[i]) + 0.5f * prev;
            v += __shfl_xor(v, 1); v += __shfl_xor(v, 2);
            if ((r32 & 3) == 0) imp_row[16 * j + 2 * i + hi] = v;
        }
        { float sp = 0.5f * own3[7]; sp += __shfl_xor(sp, 1); sp += __shfl_xor(sp, 2); if ((r32 & 3) == 0 && hi == 1) spill_row[j + 1] = sp; }
    } else {
        float pmax = p0[0];
#pragma unroll
        for (int r = 1; r < 16; ++r) pmax = fmaxf(pmax, p0[r]);
#pragma unroll
        for (int r = 0; r < 16; ++r) pmax = fmaxf(pmax, p1[r]);
        if (MODE == BR_SEL) pmax = rowoff ? NEG : pmax;
        { auto rr = __builtin_amdgcn_permlane32_swap(__float_as_uint(pmax), __float_as_uint(pmax), false, false); pmax = fmaxf(__uint_as_float(rr[0]), __uint_as_float(rr[1])); }
        float mn, alpha;
        if (DEFER_THR > 0.f && __all((pmax - St.m) * C2 <= DEFER_THR)) { mn = St.m; alpha = 1.f; }
        else { mn = fmaxf(St.m, pmax); alpha = __builtin_amdgcn_exp2f((St.m - mn) * C2); St.m = mn; }
        float mnL = -mn * C2;
        if (MODE == BR_SEL) mnL = rowoff ? NEG : mnL;
        float ps = 0.f;
#pragma unroll
        for (int r = 0; r < 16; ++r) { p0[r] = __builtin_amdgcn_exp2f(fmaf(p0[r], C2, mnL)); ps += p0[r]; }
#pragma unroll
        for (int r = 0; r < 16; ++r) { p1[r] = __builtin_amdgcn_exp2f(fmaf(p1[r], C2, mnL)); ps += p1[r]; }
        { auto rr = __builtin_amdgcn_permlane32_swap(__float_as_uint(ps), __float_as_uint(ps), false, false); ps = __uint_as_float(rr[0]) + __uint_as_float(rr[1]); }
        St.l = St.l * alpha + ps;
        if (MODE != BR_CMP1 && __any(alpha < 1.f)) {
            if (hi == 0) al_l[r32] = alpha;
            asm volatile("s_waitcnt lgkmcnt(0)" ::: "memory");
            int h4 = 4 * hi; asm volatile("" : "+v"(h4));
            const LAS float* alb = al_l + h4;
#pragma unroll
            for (int r = 0; r < 16; ++r) { const float a = alb[(r & 3) + 8 * (r >> 2)];
#pragma unroll
                for (int d = 0; d < 4; ++d) St.o[d][r] *= a; }
            asm volatile("s_waitcnt lgkmcnt(0)" ::: "memory");
        }
    }
    if (MODE != BR_CMP1) {
#define FA_PK4(P, B_, OUT) do { unsigned a0 = cvtpk(P[B_ + 0], P[B_ + 1]), a1 = cvtpk(P[B_ + 2], P[B_ + 3]); \
        unsigned b0 = cvtpk(P[B_ + 4], P[B_ + 5]), b1 = cvtpk(P[B_ + 6], P[B_ + 7]); \
        auto r0 = __builtin_amdgcn_permlane32_swap(a0, b0, false, false); auto r1 = __builtin_amdgcn_permlane32_swap(a1, b1, false, false); \
        v4u w_ = {r0[0], r1[0], r0[1], r1[1]}; OUT = *reinterpret_cast<bf16x8*>(&w_); } while (0)
        FA_PK4(p0, 0, pa0); FA_PK4(p0, 8, pa1); FA_PK4(p1, 0, pa2); FA_PK4(p1, 8, pa3);
#undef FA_PK4
    }
}

template <int MODE, bool SHARED, int NST, bool KEEPH0 = false, bool PVF = false>
__device__ __forceinline__ void flash_branch3(FlashState& St, const fa::bf16x8* qr, const bf16* Kg, const bf16* Vg, size_t ld, int jf, int jl, int nsteps, int jclamp,
                                              LAS char* lds, LAS float* al_l, int tl, unsigned sw0, unsigned sw1, unsigned sw2, unsigned sw3, int cur,
                                              int w, int lane_in, float mfix = 0.f, float invl = 0.f, LAS float* imp_row = nullptr, LAS float* spill_row = nullptr) {
    using namespace fa;
    static_assert(!PVF || (MODE == BR_SEL || MODE == BR_WIN), "PVF: branches with a P V only");
    int lane = lane_in; asm volatile("" : "+v"(lane));
    const int r32 = lane & 31, hi = lane >> 5, wq = w & 3, half = w >> 2;
    constexpr int NP = SHARED ? 2 : 4;
    unsigned koff[2], voff0;
#pragma unroll
    for (int i = 0; i < 2; ++i) {
        const int cidx = SHARED ? w * 2 + i : wq * 4 + i;
        const int krow = cidx * 4 + (lane >> 4), kcolB = ((lane & 15) * 16) ^ ((krow & 7) << 4);
        koff[i] = (unsigned)((size_t)krow * ld * 2) + (unsigned)kcolB;
    }
    {
        const int cidx = SHARED ? w * 2 : wq * 4;
        const int sub = cidx * 2 + (lane >> 5), khi = sub >> 2, cblk = sub & 3, klo = (lane & 31) >> 2, cin = (lane & 3) * 8, kk = khi * 8 + klo;
        const int vk = (kk & ~0xC) | ((kk & 4) << 1) | ((kk & 8) >> 1), vc = cblk * 32 + cin;
        voff0 = (unsigned)((size_t)vk * ld * 2) + (unsigned)(vc * 2);
    }
    const int vlag = PVF ? (SHARED ? 1 : half) : 0;
#define FB3_STAGE(k) (lds + (SHARED ? (((k) + NST) & (NST - 1)) : (((k) & 1) * 2 + half)) * (2 * SHM_T))
#define FB3_ISSUE(k) do { int jt_ = jf + (k); jt_ = jt_ > jclamp ? jclamp : jt_; int jv_ = jf + (k) - vlag; jv_ = jv_ < jf ? jf : jv_; jv_ = jv_ > jclamp ? jclamp : jv_; \
        const char* kbase_ = (const char*)Kg + (size_t)(64 * jt_) * ld * 2; const char* vbase_ = (const char*)Vg + (size_t)(64 * jv_) * ld * 2; \
        LAS char* kt_ = FB3_STAGE(k) + (SHARED ? w * 2048 : wq * 4096); LAS char* vt_ = FB3_STAGE((k) - vlag) + SHM_T + (SHARED ? w * 2048 : wq * 4096); \
        _Pragma("unroll") for (int i_ = 0; i_ < NP; ++i_) { \
            __builtin_amdgcn_global_load_lds((const unsigned*)(kbase_ + (size_t)(i_ >> 1) * (8 * ld * 2) + koff[i_ & 1]), (LAS unsigned*)(kt_ + i_ * 1024), 16, 0, 0); \
            __builtin_amdgcn_global_load_lds((const unsigned*)(vbase_ + ((size_t)(i_ >> 1) * (4 * ld * 2) + (i_ & 1) * 128) + voff0), (LAS unsigned*)(vt_ + i_ * 1024), 16, 0, 0); } } while (0)
#define FB3_SYNC() do { if (NST == 4) { if (PVF) asm volatile("s_waitcnt vmcnt(4) lgkmcnt(0)" ::: "memory"); else asm volatile("s_waitcnt vmcnt(8) lgkmcnt(0)" ::: "memory"); } \
        else asm volatile("s_waitcnt vmcnt(0) lgkmcnt(0)" ::: "memory"); \
        __builtin_amdgcn_s_barrier(); asm volatile("" ::: "memory"); } while (0)
#define FB3_ACTIVE(j_, act_, roff_) do { act_ = (j_) <= jl; roff_ = false; \
        if (MODE == BR_SEL) { const unsigned swj_ = (j_) < 32 ? sw0 : ((j_) < 64 ? sw1 : ((j_) < 96 ? sw2 : sw3)); roff_ = ((swj_ >> ((j_) & 31)) & 1u) == 0u; \
            if (SEL_SKIP && __all(roff_)) act_ = false; } } while (0)
    if (!KEEPH0) {
#pragma unroll
        for (int d = 0; d < 4; ++d) St.o[d] = f32x16{};
        St.m = -1e30f; St.l = 0.f;
    } else {
        float kf = half == 0 ? 1.f : 0.f; asm volatile("" : "+v"(kf));
#pragma unroll
        for (int d = 0; d < 4; ++d) St.o[d] *= kf;
        St.m = half == 0 ? St.m : -1e30f; St.l *= kf;
    }
#pragma unroll
    for (int s_ = 0; s_ < NST - 1; ++s_) FB3_ISSUE(s_);
    if (HALF_PRIO && half == (HALF_PRIO_WHO)) __builtin_amdgcn_s_setprio(HALF_PRIO);
    if (!(PVF && half)) {
        for (int step = 0; step < nsteps; ++step) {
            FB3_SYNC();
            constexpr bool LATE = DMA_LATE != 0 && MODE != BR_CMP1 && NST == 4;
            if (!LATE) FB3_ISSUE(step + NST - 1);
            const int j = jf + step; bool active, rowoff; FB3_ACTIVE(j, active, rowoff);
            if (LATE && !active) FB3_ISSUE(step + NST - 1);
            if (active) {
                const LAS char* K_t = FB3_STAGE(step);
                const int vb0 = (int)(unsigned)(size_t)(K_t + SHM_T) + v_rd_base(lane);
                VSet sA; bf16x8 pa0, pa1, pa2, pa3;
                constexpr bool EV = PV_DB != 0 && !(PVF && !PVF_EARLYV);
                fb3_qksm<MODE, EV>(St, qr, K_t, vb0, sA, pa0, pa1, pa2, pa3, j, tl, cur, rowoff, al_l, r32, hi, mfix, invl, imp_row, spill_row);
                if (MODE != BR_CMP1) {
                    if (PV_DB) { __builtin_amdgcn_sched_barrier(0); if (!EV) { v_issue<0>(sA, vb0); __builtin_amdgcn_sched_barrier(0); } pv_tile_db(St.o, vb0, sA, pa0, pa1, pa2, pa3); } else pv_tile(St.o, vb0, pa0, pa1, pa2, pa3);
                }
                if (LATE) { __builtin_amdgcn_sched_barrier(0); FB3_ISSUE(step + NST - 1); }
            }
        }
        asm volatile("s_waitcnt vmcnt(0) lgkmcnt(0)" ::: "memory");
        __builtin_amdgcn_s_barrier(); asm volatile("" ::: "memory");
        if (PVF) { __builtin_amdgcn_s_barrier(); asm volatile("" ::: "memory"); }
    } else {
        bf16x8 pa0 = {}, pa1 = {}, pa2 = {}, pa3 = {}; bool pend = false; int vbp = 0;
        for (int step = 0; step < nsteps; ++step) {
            FB3_SYNC();
            FB3_ISSUE(step + NST - 1);
            if (pend) { VSet sA; v_issue<0>(sA, vbp); __builtin_amdgcn_sched_barrier(0); pv_tile_db(St.o, vbp, sA, pa0, pa1, pa2, pa3); }
            const int j = jf + step; bool active, rowoff; FB3_ACTIVE(j, active, rowoff);
            pend = active;
            if (active) {
                const LAS char* K_t = FB3_STAGE(step);
                vbp = (int)(unsigned)(size_t)(K_t + SHM_T) + v_rd_base(lane);
                VSet sU;
                fb3_qksm<MODE, false>(St, qr, K_t, vbp, sU, pa0, pa1, pa2, pa3, j, tl, cur, rowoff, al_l, r32, hi, mfix, invl, imp_row, spill_row);
            }
        }
        asm volatile("s_waitcnt vmcnt(0) lgkmcnt(0)" ::: "memory");
        __builtin_amdgcn_s_barrier(); asm volatile("" ::: "memory");
        if (pend) { VSet sA; v_issue<0>(sA, vbp); __builtin_amdgcn_sched_barrier(0); pv_tile_db(St.o, vbp, sA, pa0, pa1, pa2, pa3); }
        asm volatile("s_waitcnt lgkmcnt(0)" ::: "memory");
        __builtin_amdgcn_s_barrier(); asm volatile("" ::: "memory");
    }
    if (HALF_PRIO) __builtin_amdgcn_s_setprio(0);
#undef FB3_ACTIVE
#undef FB3_SYNC
#undef FB3_ISSUE
#undef FB3_STAGE
}

template <bool FIRST, bool LAST>
__device__ __forceinline__ void nsa3_finish(const FlashState& St, float scale, LAS float* al_l, float* accw  , bf16* outw, int lane_in) {
    int lane = lane_in; asm volatile("" : "+v"(lane));
    const int r32 = lane & 31, hi = lane >> 5;
    if (hi == 0) al_l[r32] = scale;
    asm volatile("s_waitcnt lgkmcnt(0)" ::: "memory");
    int h4 = 4 * hi; asm volatile("" : "+v"(h4));
    const LAS float* alb = al_l + h4;
    float* const abase = accw + hi * 1024 + r32; bf16* const obase = outw + hi * 1024 + r32;
#pragma unroll
    for (int r4 = 0; r4 < 16; r4 += 8) {
        float av[8][4];
#pragma unroll
        for (int rr = 0; rr < 8; ++rr) { const int r = r4 + rr, roff = (2 * (r >> 2)) * 1024 + (r & 3) * 128;
#pragma unroll
            for (int d = 0; d < 4; ++d) av[rr][d] = FIRST ? 0.f : abase[roff + d * 32]; }
#pragma unroll
        for (int rr = 0; rr < 8; ++rr) { const int r = r4 + rr, roff = (2 * (r >> 2)) * 1024 + (r & 3) * 128;
            const float sc = alb[(r & 3) + 8 * (r >> 2)];
#pragma unroll
            for (int d = 0; d < 4; ++d) {
                const float v = St.o[d][r] * sc + av[rr][d];
                if (LAST) { const float vn = __shfl_xor(v, 1); if ((r32 & 1) == 0) *(unsigned*)(obase + roff + d * 32) = fa::cvtpk(v, vn); }
                else abase[roff + d * 32] = v;
            } }
        asm volatile("" ::: "memory");
    }
    asm volatile("s_waitcnt lgkmcnt(0)" ::: "memory");
}

__device__ __forceinline__ void nsa3_merge(FlashState& St, float gate, LAS char* lds, LAS float* al_l, int w, int lane_in) {
    int lane = lane_in; asm volatile("" : "+v"(lane));
    const int r32 = lane & 31, hi = lane >> 5, wq = w & 3, half = w >> 2;
    LAS float* mrg = (LAS float*)lds + wq * 4096 + lane;
    LAS float* mlx = (LAS float*)(lds + 65536) + wq * 128;
    if (half) {
#pragma unroll
        for (int d = 0; d < 4; ++d)
#pragma unroll
            for (int r = 0; r < 16; ++r) mrg[(d * 16 + r) * 64] = St.o[d][r];
        if (hi == 0) { mlx[r32] = St.m; mlx[32 + r32] = St.l; }
    }
    asm volatile("s_waitcnt lgkmcnt(0)" ::: "memory"); __builtin_amdgcn_s_barrier(); asm volatile("" ::: "memory");
    if (!half) {
        const float m1 = mlx[r32], l1 = mlx[32 + r32];
        const float m = fmaxf(St.m, m1);
        const float e0 = __builtin_amdgcn_exp2f((St.m - m) * fa::C2), e1 = __builtin_amdgcn_exp2f((m1 - m) * fa::C2);
        const float lt = St.l * e0 + l1 * e1, sc = gate * (lt > 0.f ? 1.0f / lt : 0.f);
        if (hi == 0) { al_l[r32] = e0 * sc; mlx[64 + r32] = e1 * sc; }
        asm volatile("s_waitcnt lgkmcnt(0)" ::: "memory");
        int h4 = 4 * hi; asm volatile("" : "+v"(h4));
        const LAS float* a0b = al_l + h4; const LAS float* a1b = mlx + 64 + h4;
#pragma unroll
        for (int r = 0; r < 16; ++r) { const float a0 = a0b[(r & 3) + 8 * (r >> 2)], a1 = a1b[(r & 3) + 8 * (r >> 2)];
#pragma unroll
            for (int d = 0; d < 4; ++d) St.o[d][r] = St.o[d][r] * a0 + mrg[(d * 16 + r) * 64] * a1; }
    }
    asm volatile("s_waitcnt lgkmcnt(0)" ::: "memory"); __builtin_amdgcn_s_barrier(); asm volatile("" ::: "memory");
}

__device__ __forceinline__ void nsa3_phase(Frame& F, int l) {
    using namespace fa;
    const int tid = F.tid, lane = F.lane, w = F.wave, wq = w & 3, half = w >> 2, r32 = lane & 31, hi = lane >> 5;
    LAS char* lds = (LAS char*)F.lds;
    LAS float* al_l = (LAS float*)(lds + FL_TAB) + w * 32;
    LAS float* gate_l = (LAS float*)(lds + FL_TAB + 1024);
    LAS unsigned* selm = (LAS unsigned*)(gate_l + 768);
    LAS float* imp_l = (LAS float*)(lds + 4 * SHM_T);
    LAS float* spill_l = imp_l + 64 * 128;
    const bf16* kcmp = (const bf16*)(F.ws + WS_KCMP); const bf16* vcmp = (const bf16*)(F.ws + WS_VCMP);
    const bf16* z = (const bf16*)(F.ws + WS_Z);
    float* accb = (float*)(F.ws + WS_PART);
    bf16* attn = (bf16*)(F.ws + WS_ATTN);
    const bf16* kvc = (const bf16*)(F.ws + WS_KVC);
    for (int item = F.bid; item < 256; item += F.G) {
        const int g = item & 1, a = item >> 1;
        const int uu0 = 255 - a, uu1 = a, uu = half ? uu1 : uu0;
        const int t0 = 32 * uu, cur = t0 >> 6, cur0 = (32 * uu0) >> 6;
        const int tl = t0 + 8 * wq + (r32 >> 2), head = g * 4 + (r32 & 3);
        const int tokidx = half * 32 + 8 * wq + (r32 >> 2);
        bf16x8 qr[8];
#pragma unroll
        for (int d0 = 0; d0 < 8; ++d0) qr[d0] = *(const bf16x8*)((const bf16*)(F.ws + WS_QR) + (size_t)tl * 1024 + head * 128 + d0 * 16 + hi * 8);
        asm volatile("s_waitcnt lgkmcnt(0)" ::: "memory"); __builtin_amdgcn_s_barrier(); asm volatile("" ::: "memory");
        if (tid < 256) { const int row = tid, h_ = row >> 7, wq_ = (row >> 5) & 3, c_ = row & 31, tok = 32 * (h_ ? uu1 : uu0) + 8 * wq_ + (c_ >> 2), hh = g * 4 + (c_ & 3);
#pragma unroll
            for (int br = 0; br < 3; ++br) gate_l[br * 256 + row] = sigmoidf_(bf2f(z[(size_t)tok * ZLD + ZAG + hh * 3 + br])); }
        asm volatile("s_waitcnt lgkmcnt(0)" ::: "memory"); __builtin_amdgcn_s_barrier(); asm volatile("" ::: "memory");
        const int rowwg = half * 128 + wq * 32 + r32;
        float* const accw = accb + (size_t)(t0 + 8 * wq) * 1024 + g * 512; bf16* const outw = attn + (size_t)(t0 + 8 * wq) * 1024 + g * 512;
        FlashState St;
        {
            const int jlc = (t0 >> 4) >> 6, jlc0 = ((32 * uu0) >> 4) >> 6; float mfix = 0.f, invl = 0.f;
            for (int rep_ = 0; rep_ < REP_CMPB; ++rep_) {
            flash_branch3<BR_CMP1, true, 2>(St, qr, kcmp + g * 128, vcmp + g * 128, (size_t)256, 0, jlc, jlc0 + 1, jlc0, lds, al_l, tl, 0u, 0u, 0u, 0u, cur, w, lane);
            mfix = St.m; invl = St.l > 0.f ? 1.0f / St.l : 0.f;
            flash_branch3<BR_CMP2, true, 2>(St, qr, kcmp + g * 128, vcmp + g * 128, (size_t)256, 0, jlc, jlc0 + 1, jlc0, lds, al_l, tl, 0u, 0u, 0u, 0u, cur, w, lane, mfix, invl, imp_l + tokidx * 128, spill_l + tokidx * 9);
            }
            nsa3_finish<true, false>(St, gate_l[0 * 256 + rowwg], al_l, accw, outw, lane);
            {
                const int K = cur + 1 < TOPK ? cur + 1 : TOPK;
                LAS unsigned* keys = (LAS unsigned*)(lds + FL_TAB + 5120) + w * 128;
                for (int ttr = 0; ttr < 8 * REP_TOPK; ++ttr) { const int tt = ttr & 7;
                    const int tk = 8 * w + tt;
                    unsigned cv0, cv1;
                    { const int m = lane; float imp = 0.f; if (m <= cur) { imp = imp_l[tk * 128 + m]; if ((m & 15) == 0 && m > 0) imp += spill_l[tk * 9 + (m >> 4)]; }
                      const bool forced = (m == 0) || (m == cur) || (m == cur - 1); cv0 = (m > cur) ? 0u : (forced ? 0x7f800001u : __float_as_uint(imp) + 1u); }
                    { const int m = lane + 64; float imp = 0.f; if (m <= cur) { imp = imp_l[tk * 128 + m]; if ((m & 15) == 0) imp += spill_l[tk * 9 + (m >> 4)]; }
                      const bool forced = (m == cur) || (m == cur - 1); cv1 = (m > cur) ? 0u : (forced ? 0x7f800001u : __float_as_uint(imp) + 1u); }
#if TOPK_RADIX
                    unsigned long long b0 = 0ull, b1 = 0ull;
                    {
                        unsigned long long cand0 = __ballot(cv0 != 0u), cand1 = __ballot(cv1 != 0u);
                        int kk = K;
                        const unsigned i0 = (unsigned)(255 - lane), i1 = (unsigned)(191 - lane);
                        for (int b = 39; b >= 0; --b) {
                            const int nc = __popcll(cand0) + __popcll(cand1);
                            if (nc <= kk) break;
                            const bool t0 = b >= 8 ? ((cv0 >> (b - 8)) & 1u) != 0u : ((i0 >> b) & 1u) != 0u;
                            const bool t1 = b >= 8 ? ((cv1 >> (b - 8)) & 1u) != 0u : ((i1 >> b) & 1u) != 0u;
                            const unsigned long long o0 = __ballot(t0) & cand0, o1 = __ballot(t1) & cand1;
                            const int cnt = __popcll(o0) + __popcll(o1);
                            if (cnt >= kk) { cand0 = o0; cand1 = o1; }
                            else { b0 |= o0; b1 |= o1; kk -= cnt; cand0 &= ~o0; cand1 &= ~o1; }
                        }
                        b0 |= cand0; b1 |= cand1;
                    }
#else
                    keys[lane] = cv0; keys[lane + 64] = cv1;
                    asm volatile("s_waitcnt lgkmcnt(0)" ::: "memory");
                    const unsigned long long k0 = ((unsigned long long)cv0 << 8) | (unsigned)(255 - lane), k1 = ((unsigned long long)cv1 << 8) | (unsigned)(191 - lane);
                    int rk0 = 0, rk1 = 0;
                    const int mend = (cur + 4) & ~3;
                    for (int m4 = 0; m4 < mend; m4 += 4) { const v4u kq = *(const LAS v4u*)(keys + m4);
#pragma unroll
                        for (int e = 0; e < 4; ++e) { const unsigned long long ko = ((unsigned long long)kq[e] << 8) | (unsigned)(255 - (m4 + e));
                            rk0 += ko > k0 ? 1 : 0; rk1 += ko > k1 ? 1 : 0; } }
                    const unsigned long long b0 = __ballot(cv0 != 0u && rk0 < K), b1 = __ballot(cv1 != 0u && rk1 < K);
#endif
                    if (lane == 0) { selm[tk * 4 + 0] = (unsigned)b0; selm[tk * 4 + 1] = (unsigned)(b0 >> 32); selm[tk * 4 + 2] = (unsigned)b1; selm[tk * 4 + 3] = (unsigned)(b1 >> 32); }
                    asm volatile("s_waitcnt lgkmcnt(0)" ::: "memory");
                }
            }
            asm volatile("s_waitcnt lgkmcnt(0)" ::: "memory"); __builtin_amdgcn_s_barrier(); asm volatile("" ::: "memory");
        }
        unsigned sw0 = selm[tokidx * 4 + 0], sw1 = selm[tokidx * 4 + 1], sw2 = selm[tokidx * 4 + 2], sw3 = selm[tokidx * 4 + 3];
#if SEL_SPLIT
        {
            const int cur1 = (32 * uu1) >> 6;
            flash_branch3<BR_SEL, true, 4, false, SEL_PVF>(St, qr, kvc + (size_t)(0 * 2 + g) * S * 128, kvc + (size_t)(1 * 2 + g) * S * 128, (size_t)128, 0, cur1, IDLE_MUL * (cur1 + 1), cur1, lds, al_l, tl, sw0, sw1, sw2, sw3, cur, w, lane);
            const int tl2 = 32 * uu0 + 8 * wq + (r32 >> 2);
            if (half) {
                nsa3_finish<false, false>(St, gate_l[1 * 256 + rowwg] * (St.l > 0.f ? 1.0f / St.l : 0.f), al_l, accw, outw, lane);
                const int tk2 = 8 * wq + (r32 >> 2);
                sw0 = selm[tk2 * 4 + 0]; sw1 = selm[tk2 * 4 + 1]; sw2 = selm[tk2 * 4 + 2]; sw3 = selm[tk2 * 4 + 3];
#pragma unroll
                for (int d0 = 0; d0 < 8; ++d0) qr[d0] = *(const bf16x8*)((const bf16*)(F.ws + WS_QR) + (size_t)tl2 * 1024 + head * 128 + d0 * 16 + hi * 8);
            }
            const int R = cur0 - cur1, y = (R + 1) >> 1;
            const int jf2 = half ? cur1 + 1 + y : cur1 + 1, jl2 = half ? cur0 : cur1 + y;
            flash_branch3<BR_SEL, false, 2, true, SEL_PVF2>(St, qr, kvc + (size_t)(0 * 2 + g) * S * 128, kvc + (size_t)(1 * 2 + g) * S * 128, (size_t)128, jf2, jl2, IDLE_MUL * y, jl2, lds, al_l, tl2, sw0, sw1, sw2, sw3, cur0, w, lane);
            nsa3_merge(St, gate_l[1 * 256 + wq * 32 + r32], lds, al_l, w, lane);
            if (!half) nsa3_finish<false, false>(St, 1.0f, al_l, accw, outw, lane);
            else {
#pragma unroll
                for (int d0 = 0; d0 < 8; ++d0) qr[d0] = *(const bf16x8*)((const bf16*)(F.ws + WS_QR) + (size_t)tl * 1024 + head * 128 + d0 * 16 + hi * 8);
            }
        }
#else
        for (int rep_ = 0; rep_ < REP_SELB; ++rep_)
        flash_branch3<BR_SEL, true, 4>(St, qr, kvc + (size_t)(0 * 2 + g) * S * 128, kvc + (size_t)(1 * 2 + g) * S * 128, (size_t)128, 0, cur, cur0 + 1, cur0, lds, al_l, tl, sw0, sw1, sw2, sw3, cur, w, lane);
        nsa3_finish<false, false>(St, gate_l[1 * 256 + rowwg] * (St.l > 0.f ? 1.0f / St.l : 0.f), al_l, accw, outw, lane);
#endif
        {
            const int jf = (t0 - (WINDOW - 1)) < 0 ? 0 : (t0 - (WINDOW - 1)) >> 6;
            const int t00 = 32 * uu0, t01 = 32 * uu1;
            const int n0 = (t00 >> 6) - ((t00 - (WINDOW - 1)) < 0 ? 0 : (t00 - (WINDOW - 1)) >> 6) + 1, n1 = (t01 >> 6) - ((t01 - (WINDOW - 1)) < 0 ? 0 : (t01 - (WINDOW - 1)) >> 6) + 1;
            for (int rep_ = 0; rep_ < REP_WINB; ++rep_)
            flash_branch3<BR_WIN, false, 2, false, WIN_PVF>(St, qr, kvc + (size_t)(2 * 2 + g) * S * 128, kvc + (size_t)(3 * 2 + g) * S * 128, (size_t)128, jf, cur, n0 > n1 ? n0 : n1, cur, lds, al_l, tl, 0u, 0u, 0u, 0u, cur, w, lane);
            nsa3_finish<false, true>(St, gate_l[2 * 256 + rowwg] * (St.l > 0.f ? 1.0f / St.l : 0.f), al_l, accw, outw, lane);
        }
    }
}

namespace hgm {
typedef short bf16x8 __attribute__((ext_vector_type(8)));
constexpr int HQ = 136, HS = 72;
constexpr int QV_OFF = 0, KV_OFF = 112 * HQ * 2, QC_OFF = KV_OFF + 112 * HQ * 2, ST_OFF = QC_OFF + 64 * HQ * 2, VT_OFF = ST_OFF + 128 * HQ * 2, AL_OFF = VT_OFF + 128 * HS * 2,
              TOT_OFF = AL_OFF + 64 * HS * 2, SSQ_OFF = TOT_OFF + 4 * 128 * 4, KT_OFF = 0;
static_assert(SSQ_OFF + 64 * 2 * 4 <= LDSCTL_OFF, "HGRN LDS map");
struct Prep { float q[16], k[16], v[16], b[16]; float B1, B2, B3, B4; };
struct Raw { bf16 f[16], q[16], v[16]; };
template <bool WITHQ>
__device__ __forceinline__ void load_raw(Frame& F, int c, int h, Raw& R) {
    const int I = F.tid >> 7, d = F.tid & 127;
    const bf16* zr = (const bf16*)(F.ws + WS_Z) + (size_t)(c * HGC + 16 * I) * ZLD + h * 128 + d;
#pragma unroll
    for (int i = 0; i < 16; ++i) { const bf16* zp = zr + (size_t)i * ZLD; R.f[i] = zp[ZFH]; R.q[i] = WITHQ ? zp[ZQH] : (bf16)0; R.v[i] = zp[ZIH]; }
}
__device__ __forceinline__ void prep(Frame& F, int l, int h, const Raw& R, Prep& P, LAS float* tot) {
    const int I = F.tid >> 7, d = F.tid & 127;
    const float lb = ((const float*)(F.ws + WS_LB))[l * 1024 + h * 128 + d];
    float run = 0.f;
#pragma unroll
    for (int i = 0; i < 16; ++i) {
        const float x = fminf(fmaxf(bf2f(R.f[i]), -80.f), 80.f);
        const float sp = __builtin_amdgcn_rcpf(1.0f + __expf(-x)), sn = __builtin_amdgcn_rcpf(1.0f + __expf(x));
        const float lf = __logf(lb + (1.0f - lb) * sp); run += lf; P.b[i] = run; P.k[i] = (1.0f - lb) * sn; P.q[i] = bf2f(R.q[i]); P.v[i] = bf2f(R.v[i]); }
    tot[I * 128 + d] = run;
    __syncthreads();
    P.B1 = tot[d]; P.B2 = P.B1 + tot[128 + d]; P.B3 = P.B2 + tot[256 + d]; P.B4 = P.B3 + tot[384 + d];
    const float BI = I == 0 ? 0.f : (I == 1 ? P.B1 : (I == 2 ? P.B2 : P.B3));
#pragma unroll
    for (int i = 0; i < 16; ++i) P.b[i] += BI;
}
__device__ __forceinline__ bf16 tobf(float x) { return (bf16)f2bf(x); }
}

__device__ __forceinline__ void hgrn_pass1_mfma(Frame& F, int l) {
    using namespace hgm;
    const int lane = F.lane, w = F.wave, fr = lane & 15, fq = lane >> 4;
    LAS bf16* KT = (LAS bf16*)(F.lds + KT_OFF);
    LAS bf16* VT = (LAS bf16*)(F.lds + VT_OFF);
    LAS float* tot = (LAS float*)(F.lds + TOT_OFF);
    float* hgD = (float*)(F.ws + WS_HGD); float* hgS = (float*)(F.ws + WS_HGS);
    Raw Rn; if (F.bid < HGNC * 8) load_raw<false>(F, F.bid >> 3, F.bid & 7, Rn);
    for (int it = F.bid; it < HGNC * 8; it += F.G) {
        const int c = it >> 3, h = it & 7, I = F.tid >> 7, d = F.tid & 127;
        const Raw Rc = Rn;
        if (it + F.G < HGNC * 8) load_raw<false>(F, (it + F.G) >> 3, (it + F.G) & 7, Rn);
        Prep P; prep(F, l, h, Rc, P, tot);
#pragma unroll
        for (int i = 0; i < 16; ++i) { KT[d * HS + 16 * I + i] = tobf(P.k[i] * __expf(P.B4 - P.b[i])); VT[d * HS + 16 * I + i] = tobf(P.v[i]); }
        if (I == 0) hgD[(size_t)it * 128 + d] = __expf(P.B4);
        __syncthreads();
        pg8::f32x4 acc[8];
#pragma unroll
        for (int dt = 0; dt < 8; ++dt) acc[dt] = (pg8::f32x4){0.f, 0.f, 0.f, 0.f};
#pragma unroll
        for (int ks = 0; ks < 2; ++ks) {
            const bf16x8 af = *(const LAS bf16x8*)(VT + (16 * w + fr) * HS + 32 * ks + 8 * fq);
#pragma unroll
            for (int dt = 0; dt < 8; ++dt) { const bf16x8 bfg = *(const LAS bf16x8*)(KT + (16 * dt + fr) * HS + 32 * ks + 8 * fq);
                acc[dt] = __builtin_amdgcn_mfma_f32_16x16x32_bf16(af, bfg, acc[dt], 0, 0, 0); }
        }
        bf16* o = (bf16*)hgS + (size_t)it * 16384 + (size_t)(16 * w + 4 * fq) * 128 + fr;
#pragma unroll
        for (int dt = 0; dt < 8; ++dt)
#pragma unroll
            for (int e = 0; e < 4; ++e) o[e * 128 + 16 * dt] = tobf(acc[dt][e]);
        __syncthreads();
    }
}

__device__ __forceinline__ void hgrn_pass3_mfma(Frame& F, int l) {
    using namespace hgm;
    const int lane = F.lane, w = F.wave, fr = lane & 15, fq = lane >> 4, tid = F.tid;
    LAS bf16* QV = (LAS bf16*)(F.lds + QV_OFF); LAS bf16* KV = (LAS bf16*)(F.lds + KV_OFF); LAS bf16* QC = (LAS bf16*)(F.lds + QC_OFF);
    LAS bf16* ST = (LAS bf16*)(F.lds + ST_OFF); LAS bf16* VT = (LAS bf16*)(F.lds + VT_OFF); LAS bf16* AL = (LAS bf16*)(F.lds + AL_OFF);
    LAS float* tot = (LAS float*)(F.lds + TOT_OFF); LAS float* ssq = (LAS float*)(F.lds + SSQ_OFF);
    const bf16* z = (const bf16*)(F.ws + WS_Z);
    const float* hgS = (const float*)(F.ws + WS_HGS2);
    const float* gn = inp(F, 12) + (size_t)l * 1024;
    bf16* hg = (bf16*)(F.ws + WS_HG);
    Raw Rn; v4u Sn[4];
#if HG_DYN
    unsigned* qh = (unsigned*)(F.ws + WS_CTL) + 1024 + 64 * l;
    LAS unsigned* slot = (LAS unsigned*)(F.lds + LDSCTL_OFF + 64);
    if (tid == 0) *slot = __hip_atomic_fetch_add(qh, 2u, __ATOMIC_RELAXED, __HIP_MEMORY_SCOPE_AGENT);
    __syncthreads();
    int it = (int)*slot, nxt = it + 1;
    __syncthreads();
#define HG_NEXT nxt
#else
    int it = F.bid;
#define HG_NEXT (it + F.G)
#endif
    if (it < HGNC * 8) { load_raw<true>(F, it >> 3, it & 7, Rn);
#pragma unroll
        for (int i = 0; i < 4; ++i) Sn[i] = *(const v4u*)((const bf16*)hgS + (size_t)it * 16384 + (size_t)(tid + 512 * i) * 8); }
    while (it < HGNC * 8) {
        const int c = it >> 3, h = it & 7, I = tid >> 7, d = tid & 127;
#if HG_DYN
        unsigned nq = 0u; if (tid == 0) nq = __hip_atomic_fetch_add(qh, 1u, __ATOMIC_RELAXED, __HIP_MEMORY_SCOPE_AGENT);
#endif
        const Raw Rc = Rn;
#pragma unroll
        for (int i = 0; i < 4; ++i) { const int e8 = tid + 512 * i, v = e8 >> 4, d8 = (e8 & 15) * 8; *(LAS v4u*)(ST + v * HQ + d8) = Sn[i]; }
        if (HG_NEXT < HGNC * 8) { load_raw<true>(F, (HG_NEXT) >> 3, (HG_NEXT) & 7, Rn);
#pragma unroll
            for (int i = 0; i < 4; ++i) Sn[i] = *(const v4u*)((const bf16*)hgS + (size_t)(HG_NEXT) * 16384 + (size_t)(tid + 512 * i) * 8); }
        Prep P; prep(F, l, h, Rc, P, tot);
#pragma unroll
        for (int i = 0; i < 16; ++i) {
            const int row = 16 * I + i; const float b = P.b[i], q = P.q[i], k = P.k[i];
            QC[row * HQ + d] = tobf(q * __expf(b));
            VT[d * HS + row] = tobf(P.v[i]);
            const float BI = I == 0 ? 0.f : (I == 1 ? P.B1 : (I == 2 ? P.B2 : P.B3)), BN = I == 0 ? P.B1 : (I == 1 ? P.B2 : (I == 2 ? P.B3 : P.B4));
            KV[(16 * I + i) * HQ + d] = tobf(k * __expf(fminf(BI - b, 80.f)));
            if (I < 3) KV[(16 * (4 + I) + i) * HQ + d] = tobf(k * __expf(BN - b));
            if (I == 0) QV[i * HQ + d] = tobf(q * __expf(b));
            else if (I == 1) QV[(16 + i) * HQ + d] = tobf(q * __expf(b - P.B1));
            else if (I == 2) { QV[(32 + i) * HQ + d] = tobf(q * __expf(b - P.B1)); QV[(48 + i) * HQ + d] = tobf(q * __expf(b - P.B2)); }
            else { QV[(64 + i) * HQ + d] = tobf(q * __expf(b - P.B1)); QV[(80 + i) * HQ + d] = tobf(q * __expf(b - P.B2)); QV[(96 + i) * HQ + d] = tobf(q * __expf(b - P.B3)); }
        }
        if (tid < 256) { const int blk = tid >> 7, e = tid & 127, r = e >> 3, cc = e & 7;
            const int I0 = blk == 0 ? 0 : 2, J0 = blk == 0 ? 1 : 3; *(LAS unsigned*)(AL + (16 * I0 + r) * HS + 16 * J0 + 2 * cc) = 0u; }
#if HG_DYN
        if (tid == 0) *slot = nq;
#endif
        __syncthreads();
#if HG_DYN
        const int nxt2 = (int)*slot;
#endif
        for (int bi = w; bi < 10; bi += 8) {
            int Ib, Jb;
            if (bi == 0) { Ib = 0; Jb = 0; } else if (bi < 3) { Ib = 1; Jb = bi - 1; } else if (bi < 6) { Ib = 2; Jb = bi - 3; } else { Ib = 3; Jb = bi - 6; }
            const bool diag = Ib == Jb;
            const int rref = diag ? Ib : Jb + 1;
            const int qblk = Ib == 0 ? 0 : (Ib == 1 ? 1 : (Ib == 2 ? 1 + rref : 3 + rref));
            const int kblk = diag ? Jb : 4 + Jb;
            pg8::f32x4 a = {0.f, 0.f, 0.f, 0.f};
#pragma unroll
            for (int ks = 0; ks < 4; ++ks) {
                const bf16x8 af = *(const LAS bf16x8*)(QV + (16 * qblk + fr) * HQ + 32 * ks + 8 * fq);
                const bf16x8 bfg = *(const LAS bf16x8*)(KV + (16 * kblk + fr) * HQ + 32 * ks + 8 * fq);
                a = __builtin_amdgcn_mfma_f32_16x16x32_bf16(af, bfg, a, 0, 0, 0);
            }
#pragma unroll
            for (int e = 0; e < 4; ++e) { const int tl_ = 4 * fq + e; const float val = (diag && fr > tl_) ? 0.f : a[e]; AL[(16 * Ib + tl_) * HS + 16 * Jb + fr] = tobf(val); }
        }
        __syncthreads();
        const int Iw = w >> 1, vh = w & 1;
        bf16 ogr[4][4];
#pragma unroll
        for (int e = 0; e < 4; ++e)
#pragma unroll
            for (int j = 0; j < 4; ++j) ogr[e][j] = z[(size_t)(c * HGC + 16 * Iw + 4 * fq + e) * ZLD + ZOG + h * 128 + 16 * (4 * vh + j) + fr];
        pg8::f32x4 o[4];
#pragma unroll
        for (int j = 0; j < 4; ++j) o[j] = (pg8::f32x4){0.f, 0.f, 0.f, 0.f};
        const int nks = Iw < 2 ? 1 : 2;
        for (int ks = 0; ks < nks; ++ks) {
            const bf16x8 af = *(const LAS bf16x8*)(AL + (16 * Iw + fr) * HS + 32 * ks + 8 * fq);
#pragma unroll
            for (int j = 0; j < 4; ++j) { const bf16x8 bfg = *(const LAS bf16x8*)(VT + (16 * (4 * vh + j) + fr) * HS + 32 * ks + 8 * fq);
                o[j] = __builtin_amdgcn_mfma_f32_16x16x32_bf16(af, bfg, o[j], 0, 0, 0); }
        }
#pragma unroll
        for (int ks = 0; ks < 4; ++ks) {
            const bf16x8 af = *(const LAS bf16x8*)(QC + (16 * Iw + fr) * HQ + 32 * ks + 8 * fq);
#pragma unroll
            for (int j = 0; j < 4; ++j) { const bf16x8 bfg = *(const LAS bf16x8*)(ST + (16 * (4 * vh + j) + fr) * HQ + 32 * ks + 8 * fq);
                o[j] = __builtin_amdgcn_mfma_f32_16x16x32_bf16(af, bfg, o[j], 0, 0, 0); }
        }
#pragma unroll
        for (int e = 0; e < 4; ++e) { float sq = 0.f;
#pragma unroll
            for (int j = 0; j < 4; ++j) sq += o[j][e] * o[j][e];
            sq += __shfl_xor(sq, 1); sq += __shfl_xor(sq, 2); sq += __shfl_xor(sq, 4); sq += __shfl_xor(sq, 8);
            if (fr == 0) ssq[(16 * Iw + 4 * fq + e) * 2 + vh] = sq; }
        __syncthreads();
#pragma unroll
        for (int e = 0; e < 4; ++e) {
            const int row = 16 * Iw + 4 * fq + e, tok = c * HGC + row;
            const float rr = 1.0f / sqrtf((ssq[row * 2] + ssq[row * 2 + 1]) * (1.0f / 128.0f) + EPS);
#pragma unroll
            for (int j = 0; j < 4; ++j) { const int vcol = h * 128 + 16 * (4 * vh + j) + fr;
                const float og = bf2f(ogr[e][j]);
                hg[(size_t)tok * 1024 + vcol] = tobf(o[j][e] * rr * gn[vcol] * siluf_(og)); }
        }
        __syncthreads();
#if HG_DYN
        it = nxt; nxt = nxt2;
#else
        it += F.G;
#endif
    }
#undef HG_NEXT
}

using pg8::Unit; using pg8::f32x4;
struct EpiGateF32 {
    static constexpr bool PERM = true, AFTER_DRAIN = false;
    bf16* C; int ldc; const bf16* G; int ldg;
    __device__ __forceinline__ void operator()(const pg8::f32x4 (&acc)[2][2][4][2], const Unit& u, int wr, int wc, int fr, int fq) const {
        const int row0 = u.pm * 256 + wr * 64 + fr, col0 = u.pn * 256 + wc * 32 + 8 * fq;
#pragma unroll
        for (int ai = 0; ai < 2; ++ai)
#pragma unroll
            for (int m = 0; m < 4; ++m) { const size_t row = (size_t)(row0 + ai * 128 + m * 16);
#pragma unroll
                for (int bj = 0; bj < 2; ++bj) { const int col = col0 + bj * 128;
                    const v4u gw = *(const v4u*)(G + row * ldg + col);
                    const pg8::f32x4 g0 = {sigmoidf_(bflo(gw.x)), sigmoidf_(bfhi(gw.x)), sigmoidf_(bflo(gw.y)), sigmoidf_(bfhi(gw.y))};
                    const pg8::f32x4 g1 = {sigmoidf_(bflo(gw.z)), sigmoidf_(bfhi(gw.z)), sigmoidf_(bflo(gw.w)), sigmoidf_(bfhi(gw.w))};
                    const pg8::f32x4 v0 = acc[ai][bj][m][0] * g0, v1 = acc[ai][bj][m][1] * g1;
                    v4u w; w.x = pk2(v0[0], v0[1]); w.y = pk2(v0[2], v0[3]); w.z = pk2(v1[0], v1[1]); w.w = pk2(v1[2], v1[3]);
                    *(v4u*)(C + row * ldc + col) = w; } }
    }
};
struct EpiMixBf16 {
    static constexpr bool PERM = true, AFTER_DRAIN = false;
    bf16* O; int ldc; const bf16* P; const bf16* G; int ldg;
    __device__ __forceinline__ void operator()(const pg8::f32x4 (&acc)[2][2][4][2], const Unit& u, int wr, int wc, int fr, int fq) const {
        const int row0 = u.pm * 256 + wr * 64 + fr, col0 = u.pn * 256 + wc * 32 + 8 * fq;
#pragma unroll
        for (int ai = 0; ai < 2; ++ai)
#pragma unroll
            for (int m = 0; m < 4; ++m) { const size_t row = (size_t)(row0 + ai * 128 + m * 16);
#pragma unroll
                for (int bj = 0; bj < 2; ++bj) { const int col = col0 + bj * 128;
                    const v4u gw = *(const v4u*)(G + row * ldg + col);
                    const v4u pw = *(const v4u*)(P + row * ldc + col);
                    const pg8::f32x4 p0 = {bflo(pw.x), bfhi(pw.x), bflo(pw.y), bfhi(pw.y)}, p1 = {bflo(pw.z), bfhi(pw.z), bflo(pw.w), bfhi(pw.w)};
                    const pg8::f32x4 g0 = {sigmoidf_(bflo(gw.x)), sigmoidf_(bfhi(gw.x)), sigmoidf_(bflo(gw.y)), sigmoidf_(bfhi(gw.y))};
                    const pg8::f32x4 g1 = {sigmoidf_(bflo(gw.z)), sigmoidf_(bfhi(gw.z)), sigmoidf_(bflo(gw.w)), sigmoidf_(bfhi(gw.w))};
                    const pg8::f32x4 v0 = p0 + acc[ai][bj][m][0] * g0, v1 = p1 + acc[ai][bj][m][1] * g1;
                    v4u w; w.x = pk2(v0[0], v0[1]); w.y = pk2(v0[2], v0[3]); w.z = pk2(v1[0], v1[1]); w.w = pk2(v1[2], v1[3]);
                    *(v4u*)(O + row * ldc + col) = w; } }
    }
};


struct DualOrder {
    int c;
    __device__ __forceinline__ bool next(int i, Unit& u) const {
        if (i >= 2) return false;
        int wgid = c; { const int nwg = 256, q = nwg / 8, xcd = wgid % 8, off = wgid / 8; wgid = xcd * q + off; }
        const int nN = 8, nig = 8 * nN, gid = wgid / nig, fm = gid * 8;
        u.pm = fm + ((wgid % nig) % 8) + 32 * i; u.pn = (wgid % nig) / 8 + 8 * i; return true;
    }
    __device__ __forceinline__ void a_ready(const Unit&) const {}
    __device__ __forceinline__ void done(const Unit&) const {}
};
struct EpiBranch {
    static constexpr bool PERM = true, AFTER_DRAIN = false;
    EpiGateF32 e1; EpiMixBf16 e2;
    __device__ __forceinline__ void operator()(const pg8::f32x4 (&acc)[2][2][4][2], const Unit& u, int wr, int wc, int fr, int fq) const {
        if (u.pm < 32) e1(acc, u, wr, wc, fr, fq);
        else { const Unit v{u.pm - 32, u.pn - 8}; e2(acc, v, wr, wc, fr, fq); }
    }
};

struct EpiBranchCarry {
    static constexpr bool PERM = true, AFTER_DRAIN = false, KEEP_ACC = true;
    bf16* O; int ldc; const bf16* G; int ldg;
    __device__ __forceinline__ bool keep(const Unit& u) const { return u.pm < 32; }
    __device__ __forceinline__ void operator()(pg8::f32x4 (&acc)[2][2][4][2], const Unit& u, int wr, int wc, int fr, int fq) const {
        const bool first = u.pm < 32;
        const int pm = first ? u.pm : u.pm - 32, pn = first ? u.pn : u.pn - 8;
        const int row0 = pm * 256 + wr * 64 + fr, col0 = pn * 256 + wc * 32 + 8 * fq;
#pragma unroll
        for (int ai = 0; ai < 2; ++ai)
#pragma unroll
            for (int m = 0; m < 4; ++m) { const size_t row = (size_t)(row0 + ai * 128 + m * 16);
#pragma unroll
                for (int bj = 0; bj < 2; ++bj) { const int col = col0 + bj * 128;
                    const v4u hw = *(const v4u*)(G + row * ldg + D + col);
                    float eh[8] = {bflo(hw.x), bfhi(hw.x), bflo(hw.y), bfhi(hw.y), bflo(hw.z), bfhi(hw.z), bflo(hw.w), bfhi(hw.w)};
#pragma unroll
                    for (int e = 0; e < 8; ++e) eh[e] = 1.0f + __expf(-fmaxf(eh[e], -40.0f));
                    if (first) {
                        const v4u gw = *(const v4u*)(G + row * ldg + col);
                        const float ga[8] = {bflo(gw.x), bfhi(gw.x), bflo(gw.y), bfhi(gw.y), bflo(gw.z), bfhi(gw.z), bflo(gw.w), bfhi(gw.w)};
#pragma unroll
                        for (int e = 0; e < 8; ++e) acc[ai][bj][m][e >> 2][e & 3] *= eh[e] * sigmoidf_(ga[e]);
                    } else {
                        float v[8];
#pragma unroll
                        for (int e = 0; e < 8; ++e) v[e] = acc[ai][bj][m][e >> 2][e & 3] * __builtin_amdgcn_rcpf(eh[e]);
                        v4u w; w.x = pk2(v[0], v[1]); w.y = pk2(v[2], v[3]); w.z = pk2(v[4], v[5]); w.w = pk2(v[6], v[7]);
                        *(v4u*)(O + row * ldc + col) = w;
                    } } }
    }
};

template <int N> __device__ __forceinline__ float ror16(float x) {
    return __int_as_float(__builtin_amdgcn_update_dpp(0, __float_as_int(x), 0x120 + N, 0xf, 0xf, false));
}
struct EpiConvGate {
    static constexpr bool PERM = true, AFTER_DRAIN = false;
    bf16* O; const float* cw; const float* cb;
    __device__ __forceinline__ void operator()(const pg8::f32x4 (&acc)[2][2][4][2], const Unit& u, int wr, int wc, int fr, int fq) const {
        const int cbase = u.pn * 128 + wc * 32 + 8 * fq;
#pragma unroll
        for (int n = 0; n < 2; ++n) {
            const int c0 = cbase + 4 * n;
            const pg8::f32x4 bg = *(const pg8::f32x4*)(cb + c0), bv = *(const pg8::f32x4*)(cb + DFF + c0);
            const pg8::f32x4 g0 = *(const pg8::f32x4*)(cw + c0), g1 = *(const pg8::f32x4*)(cw + NUP + c0), g2 = *(const pg8::f32x4*)(cw + 2 * NUP + c0);
            const pg8::f32x4 v0 = *(const pg8::f32x4*)(cw + DFF + c0), v1 = *(const pg8::f32x4*)(cw + NUP + DFF + c0), v2 = *(const pg8::f32x4*)(cw + 2 * NUP + DFF + c0);
#pragma unroll
            for (int ai = 0; ai < 2; ++ai) {
                const int tok0 = u.pm * 248 + 62 * (2 * ai + wr) - 2 + fr;
#pragma unroll
                for (int m = 0; m < 4; ++m) {
                    pg8::f32x4 og, ov;
#pragma unroll
                    for (int x = 0; x < 4; ++x) {
                        const float ug = acc[ai][0][m][n][x], uv = acc[ai][1][m][n][x];
                        const float pg_ = m > 0 ? acc[ai][0][m > 0 ? m - 1 : 0][n][x] : 0.f, pv_ = m > 0 ? acc[ai][1][m > 0 ? m - 1 : 0][n][x] : 0.f;
                        const float g1s = ror16<1>(fr == 15 ? pg_ : ug), g2s = ror16<2>(fr >= 14 ? pg_ : ug);
                        const float v1s = ror16<1>(fr == 15 ? pv_ : uv), v2s = ror16<2>(fr >= 14 ? pv_ : uv);
                        og[x] = bg[x] + g0[x] * g2s + g1[x] * g1s + g2[x] * ug;
                        ov[x] = bv[x] + v0[x] * v2s + v1[x] * v1s + v2[x] * uv;
                    }
                    const int tok = tok0 + 16 * m;
                    if ((m > 0 || fr >= 2) && tok < S) {
                        v2u w; w.x = pk2(siluf_(og[0]) * ov[0], siluf_(og[1]) * ov[1]); w.y = pk2(siluf_(og[2]) * ov[2], siluf_(og[3]) * ov[3]);
                        *(v2u*)(O + (size_t)tok * DFF + c0) = w;
                    }
                }
            }
        }
    }
};

__device__ __forceinline__ void make_frame(Frame& F, const Args& args, unsigned char* lds_raw) {
    F.lds = (LAS unsigned char*)lds_raw;
    F.tid = threadIdx.x; F.lane = F.tid & 63; F.wave = __builtin_amdgcn_readfirstlane(F.tid >> 6);
    F.G = gridDim.x; F.bid = blockIdx.x; F.ws = args.ws; F.out = args.out;
    for (int u = F.tid; u < (LDS_BYTES - LDSCTL_OFF) / 4; u += 512) ((LAS unsigned*)(F.lds + LDSCTL_OFF))[u] = 0u;
    __syncthreads();
    if (F.tid == 0) {
#pragma unroll
        for (int i = 0; i < 23; ++i) ((LAS unsigned long long*)(F.lds + LDSCTL_OFF + 128))[i] = (unsigned long long)args.in[i];
    }
    __syncthreads();
}
__device__ __forceinline__ void relaunder(Frame& F, const Args& args) {
    int t = threadIdx.x; asm volatile("" : "+v"(t)); F.tid = t; F.lane = t & 63; F.wave = __builtin_amdgcn_readfirstlane(t >> 6);
    int b = blockIdx.x; asm volatile("" : "+s"(b)); F.bid = b;
    unsigned char* w = args.ws; asm volatile("" : "+s"(w)); F.ws = w;
    float* o = args.out; asm volatile("" : "+s"(o)); F.out = o;
}
#ifndef REP_NSA
#define REP_NSA 1
#endif
#ifndef REP_HG
#define REP_HG 1
#endif
#ifndef REP_GEMM
#define REP_GEMM 1
#endif
constexpr int PH_PER_LAYER = 10, PH_FIRST = 3, N_PHASES = PH_FIRST + NL * PH_PER_LAYER;

__global__ void __launch_bounds__(512, 2) fwd(Args args) {
    extern __shared__ __attribute__((aligned(16))) unsigned char lds_raw[];
    Frame F; make_frame(F, args, lds_raw);
    const int lo = args.ph_lo, hi = args.ph_hi;
    unsigned* barw = (unsigned*)(F.ws + WS_CTL) + CW_BAR;
    XcdBarrier bar; bar.bar = barw; bar.x = 0; bar.st = nullptr;
    if (hi - lo > 1) bar = xcd_barrier_post(barw, (volatile LAS unsigned*)(F.lds + LDSCTL_OFF));
#define GEMMX(EPI, AOVL_) do { if (GEMM_V2) pg8::gemm_phase2<EPI, pg8::StaticOrder, G2_ALIGN, G2_SP2, AOVL_>(F.lds, g, So, E); else pg8::gemm_phase<EPI, pg8::StaticOrder, false, AOVL_>(F.lds, g, So, E, nullptr); } while (0)
#define IN(k) (lo <= (k) && (k) < hi)
#define PH(k) if (IN(k) && (relaunder(F, args), true))
#define SEAM(k) do { if (IN(k) && IN((k) + 1)) { for (int rb_ = 0; rb_ < REP_BAR; ++rb_) xcd_barrier(bar); } } while (0)

#define ada ((const float*)(F.ws + WS_ADA))
#define hbuf ((bf16*)(F.ws + WS_H2) + 2 * D)
#define resb ((bf16*)(F.ws + WS_H))
#define zbuf ((bf16*)(F.ws + WS_Z))
#define ybuf ((bf16*)(F.ws + WS_Y))
#define part ((bf16*)(F.ws + WS_PART + 32 * MiB))
#define mixed ((bf16*)(F.ws + WS_MIXED))
#define gbuf ((bf16*)(F.ws + WS_G))
#define attn ((bf16*)(F.ws + WS_ATTN))
#define hgb ((bf16*)(F.ws + WS_HG))

    PH(0) { for (int rep = 0; rep < REP_P0; ++rep) { p0_prologue(F); __syncthreads(); } } SEAM(0);
    PH(1) { p0b_ada(F); } SEAM(1);
    PH(2) { row_phase<false, true>(F, inp(F, 0), nullptr, nullptr, hbuf, nullptr, nullptr, inp(F, 5), ada + 1 * D, ada + 0 * D); } SEAM(2);

    for (int l = 0; l < NL; ++l) {
        const int pb = PH_FIRST + l * PH_PER_LAYER;
#define adal (ada + (size_t)l * NADA)
        PH(pb + 0) {
            const int ngz = (CONV_AHEAD && l + 1 < NL && F.G == 256) ? NGZ : F.G;
            pg8::Gemm g{hbuf, (const bf16*)(F.ws + WS_WIN) + (size_t)l * ZLD * D, S, ZLD, D}; pg8::StaticOrder So; So.init(S, ZLD, ngz, F.bid);
            pg8::EpiBf16<0> E{zbuf, ZLD, nullptr, 0, 0};
            if (F.bid < ngz) for (int rep = 0; rep < REP_GEMM * REP_GZ; ++rep) { GEMMX(pg8::EpiBf16<0>, false); __syncthreads(); }
            if (CONV_AHEAD && l + 1 < NL) convert_queue(F, l + 1);
        } SEAM(pb + 0);
        PH(pb + 1) { phase_c(F, l); __syncthreads(); for (int rep = 0; rep < REP_P1; ++rep) hgrn_pass1_mfma(F, l); } SEAM(pb + 1);
        PH(pb + 2) { for (int rep = 0; rep < REP_P2; ++rep) hgrn_pass2(F); __syncthreads(); for (int rep = 0; rep < REP_CMPR; ++rep) compress_mfma(F, l); } SEAM(pb + 2);
        PH(pb + 3) { for (int rep = 0; rep < REP_NSA; ++rep) { nsa3_phase(F, l); __syncthreads(); }
                     for (int rep = 0; rep < REP_HG; ++rep) { hgrn_pass3_mfma(F, l); __syncthreads(); } } SEAM(pb + 3);
        PH(pb + 4) {
            if (F.G == 256) {
                pg8::Gemm g{attn, (const bf16*)(F.ws + WS_WBA) + (size_t)l * 2 * D * 1024, 2 * S, 2 * D, 1024}; DualOrder So; So.c = F.bid;
#if BR_CARRY
                EpiBranchCarry E{mixed, D, zbuf + ZMG, ZLD};
                for (int rep = 0; rep < REP_GEMM * REP_GF; ++rep) { pg8::gemm_phase2<EpiBranchCarry, DualOrder, G2_ALIGN, G2_SP2, false>(F.lds, g, So, E); __syncthreads(); }
#else
                EpiBranch E{EpiGateF32{part, D, zbuf + ZMG, ZLD}, EpiMixBf16{mixed, D, part, zbuf + ZMG + D, ZLD}};
                for (int rep = 0; rep < REP_GEMM * REP_GF; ++rep) { if (GEMM_V2) pg8::gemm_phase2<EpiBranch, DualOrder, G2_ALIGN, G2_SP2, false>(F.lds, g, So, E); else pg8::gemm_phase<EpiBranch, DualOrder, false, false>(F.lds, g, So, E, nullptr); __syncthreads(); }
#endif
            } else {
                { pg8::Gemm g{attn, (const bf16*)(F.ws + WS_WBA) + (size_t)l * 2 * D * 1024, S, D, 1024}; pg8::StaticOrder So; So.init(S, D, F.G, F.bid);
                  EpiGateF32 E{part, D, zbuf + ZMG, ZLD}; GEMMX(EpiGateF32, false); }
                xcd_barrier(bar);
                { pg8::Gemm g{hgb, (const bf16*)(F.ws + WS_WBA) + (size_t)(l * 2 + 1) * D * 1024, S, D, 1024}; pg8::StaticOrder So; So.init(S, D, F.G, F.bid);
                  EpiMixBf16 E{mixed, D, part, zbuf + ZMG + D, ZLD}; GEMMX(EpiMixBf16, false); }
            }
        } SEAM(pb + 4);
        PH(pb + 5) {
            pg8::Gemm g{mixed, (const bf16*)(F.ws + WS_WOUT) + (size_t)l * D * D, S, D, D}; pg8::StaticOrder So; So.init(S, D, F.G, F.bid);
            pg8::EpiBf16<0> E{ybuf, D, nullptr, 0, 0};
            for (int rep = 0; rep < REP_GEMM * REP_GG; ++rep) { GEMMX(pg8::EpiBf16<0>, false); __syncthreads(); }
        } SEAM(pb + 5);
        PH(pb + 6) {
#if RES_BF16
            if (l == 0) row_phase<true, true, false, true>(F, inp(F, 0), ybuf, resb, hbuf, inp(F, 16) + (size_t)l * D, adal + 2 * D, inp(F, 17) + (size_t)l * D, adal + 4 * D, adal + 3 * D);
            else row_phase<true, true, true, true>(F, resb, ybuf, resb, hbuf, inp(F, 16) + (size_t)l * D, adal + 2 * D, inp(F, 17) + (size_t)l * D, adal + 4 * D, adal + 3 * D);
#else
            row_phase<true, true>(F, l == 0 ? inp(F, 0) : F.out, ybuf, F.out, hbuf, inp(F, 16) + (size_t)l * D, adal + 2 * D, inp(F, 17) + (size_t)l * D, adal + 4 * D, adal + 3 * D);
            for (int rep = 0; rep < REP_ROWPRE; ++rep) { __syncthreads(); row_phase<false, true>(F, F.out, nullptr, nullptr, hbuf, nullptr, nullptr, inp(F, 17) + (size_t)l * D, adal + 4 * D, adal + 3 * D); }
#endif
        } SEAM(pb + 6);
        PH(pb + 7) {
            pg8::Gemm g{(const bf16*)(F.ws + WS_H2), (const bf16*)(F.ws + WS_WUP) + (size_t)l * NUP * D, 34 * 256, NUP, D}; pg8::StaticOrder So; So.init(34 * 256, NUP, F.G, F.bid);
            EpiConvGate E{gbuf, inp(F, 19) + (size_t)l * 3 * NUP, inp(F, 20) + (size_t)l * NUP};
            for (int rep = 0; rep < REP_GEMM * REP_GU; ++rep) { GEMMX(EpiConvGate, true); __syncthreads(); }
        } SEAM(pb + 7);
        PH(pb + 8) {
            pg8::Gemm g{gbuf, (const bf16*)(F.ws + WS_WDN) + (size_t)l * D * DFF, S, D, DFF}; pg8::StaticOrder So; So.init(S, D, F.G, F.bid);
            pg8::EpiBf16<0> E{ybuf, D, nullptr, 0, 0};
            for (int rep = 0; rep < REP_GEMM * REP_GD; ++rep) { GEMMX(pg8::EpiBf16<0>, false); __syncthreads(); }
        } SEAM(pb + 8);
        PH(pb + 9) {
#if RES_BF16
            if (l + 1 < NL) row_phase<true, true, true, true>(F, resb, ybuf, resb, hbuf, inp(F, 22) + (size_t)l * D, adal + 5 * D, inp(F, 5) + (size_t)(l + 1) * D, adal + NADA + 1 * D, adal + NADA + 0 * D);
            else row_phase<true, false, true, false>(F, resb, ybuf, F.out, hbuf, inp(F, 22) + (size_t)l * D, adal + 5 * D, nullptr, nullptr, nullptr);
#else
            if (l + 1 < NL) row_phase<true, true>(F, F.out, ybuf, F.out, hbuf, inp(F, 22) + (size_t)l * D, adal + 5 * D, inp(F, 5) + (size_t)(l + 1) * D, adal + NADA + 1 * D, adal + NADA + 0 * D);
            else row_phase<true, false>(F, F.out, ybuf, F.out, hbuf, inp(F, 22) + (size_t)l * D, adal + 5 * D, nullptr, nullptr, nullptr);
#endif
        }
        if (l + 1 < NL) SEAM(pb + 9);
    }
#undef IN
#undef PH
#undef ada
#undef hbuf
#undef zbuf
#undef ybuf
#undef part
#undef mixed
#undef gbuf
#undef attn
#undef hgb
#undef adal
#undef SEAM
}
}

#ifndef MK_SINGLE
#define MK_SINGLE 0
#endif
extern "C" void kernel_launch(void* const* d_in, const int* in_sizes, int n_in, void* d_out, int out_size, void* d_ws, size_t ws_size, hipStream_t stream) {
    using namespace mk;
    static int grid = 0;
    if (grid == 0) {
        if (n_in != 23 || out_size != S * D || ws_size < WS_END) { fprintf(stderr, "kernel_launch: unexpected shapes (n_in %d out %d ws %zu)\n", n_in, out_size, ws_size); grid = -1; return; }
        int dev = 0, cus = 0, per_cu = 0;
        if (hipGetDevice(&dev) != hipSuccess || hipDeviceGetAttribute(&cus, hipDeviceAttributeMultiprocessorCount, dev) != hipSuccess) { grid = -1; return; }
        if (hipFuncSetAttribute((const void*)fwd, hipFuncAttributeMaxDynamicSharedMemorySize, LDS_BYTES) != hipSuccess) { fprintf(stderr, "kernel_launch: hipFuncSetAttribute failed\n"); grid = -1; return; }
        if (hipOccupancyMaxActiveBlocksPerMultiprocessor(&per_cu, (const void*)fwd, 512, LDS_BYTES) != hipSuccess || per_cu < 1) fprintf(stderr, "kernel_launch: occupancy query says %d\n", per_cu);
        (void)hipGetLastError();
        grid = cus;
    }
    if (grid < 0) return;
    (void)hipMemsetAsync((char*)d_ws + WS_CTL, 0, CTL_ZERO_BYTES, stream);
    Args a{};
    for (int i = 0; i < 23; ++i) a.in[i] = (const float*)d_in[i];
    a.out = (float*)d_out; a.ws = (unsigned char*)d_ws;
#if MK_SINGLE
    a.ph_lo = 0; a.ph_hi = N_PHASES;
    hipLaunchKernelGGL(fwd, dim3(grid), dim3(512), LDS_BYTES, stream, a);
#else
    for (int p = 0; p < N_PHASES; ++p) { a.ph_lo = p; a.ph_hi = p + 1; hipLaunchKernelGGL(fwd, dim3(grid), dim3(512), LDS_BYTES, stream, a); }
#endif
}
```
